# Optimizing an MI355X kernel written in HIP

```python
import jax, jax.numpy as jnp
from jax import lax
import numpy as np

D_MODEL = 2048
BATCH = 4
SEQ = 2048
DEPTH = 4

HEAD_DIM = 128
D_ATT = D_MODEL // 2
N_HEADS_ATT = D_ATT // HEAD_DIM
Q_BLOCK = 128
D_SC = D_MODEL // 4
N_GROUPS_SC = 4
SC_WIDTH = 3
D_CF = D_MODEL // 4
N_GROUPS_CF = 4
CF_WIDTH = 31
N_BRANCH = 3
D_FF = 4 * D_MODEL
N_IN = 3 * D_ATT + 3 * D_SC + 2 * D_CF + N_BRANCH * D_MODEL
RMS_EPS = 1e-6
LN_EPS = 1e-5

kernel_name = 'gated_parallel_hybrid_sb_conv_block'


def rms_norm(x, g):
    xf = x.astype(jnp.float32)
    y = xf * lax.rsqrt(jnp.mean(jnp.square(xf), axis=-1, keepdims=True) + RMS_EPS)
    return (y * g.astype(jnp.float32)).astype(x.dtype)


def layer_norm(x, g, b):
    xf = x.astype(jnp.float32)
    mu = jnp.mean(xf, axis=-1, keepdims=True)
    var = jnp.mean(jnp.square(xf - mu), axis=-1, keepdims=True)
    y = (xf - mu) * lax.rsqrt(var + LN_EPS)
    return (y * g.astype(jnp.float32) + b.astype(jnp.float32)).astype(x.dtype)


def causal_dwconv(u, w):
    K, C = w.shape
    return lax.conv_general_dilated(
        u, w[:, None, :].astype(u.dtype), window_strides=(1,), padding=[(K - 1, 0)],
        dimension_numbers=('NWC', 'WIO', 'NWC'), feature_group_count=C)


def stick_breaking_attention(q, k, v):
    S = q.shape[1]
    scale = HEAD_DIM ** -0.5
    outs = []
    for blk in range(S // Q_BLOCK):
        q0 = blk * Q_BLOCK
        kend = q0 + Q_BLOCK
        qb = q[:, q0:kend]
        kb = k[:, :kend]
        vb = v[:, :kend]
        z = jnp.einsum('bthd,bshd->bhts', qb, kb).astype(jnp.float32) * scale
        t_idx = q0 + jnp.arange(Q_BLOCK)[:, None]
        s_idx = jnp.arange(kend)[None, :]
        mask = s_idx < t_idx
        log_fail = jnp.where(mask, jax.nn.log_sigmoid(-z), 0.0)
        suffix = lax.cumsum(log_fail, axis=3, reverse=True) - log_fail
        log_a = jax.nn.log_sigmoid(z) + suffix
        a = jnp.where(mask, jnp.exp(log_a), 0.0)
        outs.append(jnp.einsum('bhts,bshd->bthd', a.astype(v.dtype), vb))
    return jnp.concatenate(outs, axis=1)


def setup_inputs(seed: int = 0) -> dict:
    key = jax.random.key(seed)
    ks = jax.random.split(key, 20)
    f32 = jnp.float32

    def nrm(k, shape, fan_in):
        return jax.random.normal(k, shape, f32) * (fan_in ** -0.5)

    def gain(k, shape):
        return jnp.ones(shape, f32) + 0.02 * jax.random.normal(k, shape, f32)

    return {
        'x': jax.random.normal(ks[0], (BATCH, SEQ, D_MODEL), f32),
        'ln_mix_pre': gain(ks[1], (DEPTH, D_MODEL)),
        'ln_mix_post': gain(ks[2], (DEPTH, D_MODEL)),
        'ln_mlp_pre': gain(ks[3], (DEPTH, D_MODEL)),
        'ln_mlp_post': gain(ks[4], (DEPTH, D_MODEL)),
        'w_in': nrm(ks[5], (DEPTH, D_MODEL, N_IN), D_MODEL),
        'conv_a_w': nrm(ks[6], (DEPTH, SC_WIDTH, D_SC), SC_WIDTH),
        'proj_a': nrm(ks[7], (DEPTH, D_SC, D_MODEL), D_SC),
        'proj_b': nrm(ks[8], (DEPTH, D_ATT, D_MODEL), D_ATT),
        'conv_c_w': nrm(ks[9], (DEPTH, CF_WIDTH, D_CF), CF_WIDTH),
        'conv_c_b': 0.02 * jax.random.normal(ks[10], (DEPTH, D_CF), f32),
        'norm_c_g': gain(ks[11], (DEPTH, D_CF)),
        'norm_c_b': 0.02 * jax.random.normal(ks[12], (DEPTH, D_CF), f32),
        'proj_c': nrm(ks[13], (DEPTH, D_CF, D_MODEL), D_CF),
        'w_o': nrm(ks[14], (DEPTH, D_MODEL, D_MODEL), D_MODEL),
        'w_up': nrm(ks[15], (DEPTH, D_MODEL, D_FF), D_MODEL),
        'w_down': nrm(ks[16], (DEPTH, D_FF, D_MODEL), D_FF),
    }


def reference(x, ln_mix_pre, ln_mix_post, ln_mlp_pre, ln_mlp_post, w_in, conv_a_w, proj_a,
              proj_b, conv_c_w, conv_c_b, norm_c_g, norm_c_b, proj_c, w_o, w_up, w_down):
    Bsz, S, _ = x.shape
    sizes = [D_ATT, D_ATT, D_ATT, D_SC, D_SC, D_SC, 2 * D_CF, N_BRANCH * D_MODEL]
    splits = [int(c) for c in np.cumsum(sizes)[:-1]]
    for l in range(DEPTH):
        h = rms_norm(x, ln_mix_pre[l])
        proj = h @ w_in[l]
        q, k, v, sc_b, sc_c, sc_u, cf_in, gate_logits = jnp.split(proj, splits, axis=-1)
        ya = (sc_b * causal_dwconv(sc_c * sc_u, conv_a_w[l])) @ proj_a[l]
        q = q.reshape(Bsz, S, N_HEADS_ATT, HEAD_DIM)
        k = k.reshape(Bsz, S, N_HEADS_ATT, HEAD_DIM)
        v = v.reshape(Bsz, S, N_HEADS_ATT, HEAD_DIM)
        yb = stick_breaking_attention(q, k, v).reshape(Bsz, S, D_ATT) @ proj_b[l]
        cf_a, cf_g = jnp.split(cf_in, 2, axis=-1)
        u = cf_a * jax.nn.sigmoid(cf_g)
        u = causal_dwconv(u, conv_c_w[l]) + conv_c_b[l]
        u = jax.nn.silu(layer_norm(u, norm_c_g[l], norm_c_b[l]))
        yc = u @ proj_c[l]
        g_a, g_b, g_c = jnp.split(jax.nn.sigmoid(gate_logits), N_BRANCH, axis=-1)
        mixed = (g_a * ya + g_b * yb + g_c * yc) @ w_o[l]
        x = x + rms_norm(mixed, ln_mix_post[l])
        h = rms_norm(x, ln_mlp_pre[l])
        f = jnp.square(jax.nn.relu(h @ w_up[l])) @ w_down[l]
        x = x + rms_norm(f, ln_mlp_post[l])
    return x
```

```cpp
#include <hip/hip_runtime.h>
#include <cstdio>
#include <cstdint>

#ifndef MK_MULTI
#define MK_MULTI 0
#endif
#ifndef PH_MASK
#define PH_MASK 0x1ff
#endif
#ifndef MK_SKEL
#define MK_SKEL 0
#endif

constexpr int D = 2048, BATCH = 4, SEQ = 2048, DEPTH = 4, M = BATCH * SEQ;
constexpr int HD = 128, DATT = 1024, NHEAD = 8, DSC = 512, DCF = 512, DFF = 8192, NIN = 11776;
constexpr int SCW = 3, CFW = 31;
constexpr float RMS_EPS = 1e-6f, LN_EPS = 1e-5f;
constexpr int C_Q = 0, C_K = 1024, C_V = 2048, C_SB = 3072, C_SC = 3584, C_SU = 4096, C_CA = 4608, C_CG = 5120, C_G = 5632;
constexpr int Z_A = 0, Z_B = 512, Z_C = 1536;
constexpr float QSCALE = 0.08838834764831845f * 1.4426950408889634f;

namespace pg8 {
#define PG8_LAS __attribute__((address_space(3)))
typedef unsigned short bf16_t;
typedef short bf16x8 __attribute__((ext_vector_type(8)));
typedef float f32x4 __attribute__((ext_vector_type(4)));
typedef unsigned u32x4 __attribute__((ext_vector_type(4)));
constexpr int BM = 256, BK = 64, HALF = 128, HTB = HALF * BK * 2, STAGE_BYTES = 8 * HTB, NXCD = 8, WGM = 8;

__host__ __device__ __forceinline__ int lds_byte(int r, int c) { const int st = (r >> 4) * 2 + (c >> 5), rr = r & 15, cc = c & 31, ob = rr * 64 + cc * 2; return st * 1024 + (ob ^ (((ob >> 9) & 1) << 5)); }
__host__ __device__ __forceinline__ void stage_rc(int b, int& R, int& C) { const int st = b / 1024, sb = b % 1024, swz = sb ^ (((sb >> 9) & 1) << 5); R = (st >> 1) * 16 + swz / 64; C = (st & 1) * 32 + (swz % 64) / 2; }
__host__ __device__ __forceinline__ int perm32(int rho) { const int n = rho >> 4, i = rho & 15; return 8 * (i >> 2) + 4 * n + (i & 3); }

struct Unit { int pm, pn; };
struct Gemm { const bf16_t* A; const bf16_t* Bt; int M, N, K; };

struct StaticOrder {
    int nM, nN, nwg, G, c;
    __host__ __device__ void init(int M_, int N_, int G_, int c_) { nM = M_ / BM; nN = N_ / BM; nwg = nM * nN; G = G_; c = c_; }
    __host__ __device__ bool next(int i, Unit& u) const {
        const long L = (long)i * G + c; if (L >= nwg) return false;
        int wgid = (int)L; { const int q = nwg / NXCD, r = nwg % NXCD, xcd = wgid % NXCD, off = wgid / NXCD; wgid = (xcd < r ? xcd * (q + 1) : r * (q + 1) + (xcd - r) * q) + off; }
        const int nig = WGM * nN, gid = wgid / nig, fm = gid * WGM, gsz = (nM - fm) < WGM ? (nM - fm) : WGM;
        u.pm = fm + ((wgid % nig) % gsz); u.pn = (wgid % nig) / gsz; return true;
    }
    __device__ __forceinline__ void a_ready(const Unit&) const {}
    __device__ __forceinline__ void done(const Unit&) const {}
};

__device__ __forceinline__ unsigned cvt_pk_bf16(float lo, float hi) { unsigned r; asm volatile("v_cvt_pk_bf16_f32 %0, %1, %2" : "=v"(r) : "v"(lo), "v"(hi)); return r; }
__device__ __forceinline__ float bf_lo(unsigned w) { return __uint_as_float(w << 16); }
__device__ __forceinline__ float bf_hi(unsigned w) { return __uint_as_float(w & 0xffff0000u); }
__device__ __forceinline__ float sigmoidf_fast(float x) { return __builtin_amdgcn_rcpf(1.0f + __builtin_amdgcn_exp2f(-1.4426950408889634f * x)); }


struct EpiIn {
    static constexpr bool PERM = true, AFTER_DRAIN = false, SEG = false; static constexpr int T1 = -1, T2 = -1;
    bf16_t* O;
    __device__ __forceinline__ void rescale(f32x4 (&)[2][2][4][2], const Unit&, int, int, int, int, int) const {}
    __device__ __forceinline__ void operator()(const f32x4 (&acc)[2][2][4][2], const Unit& u, int wr, int wc, int fr, int fq) const {
        const int row0 = u.pm * BM + wr * 64 + fr, col0 = u.pn * BM + wc * 32 + 8 * fq;
        const int mode = (u.pn < 4) ? 1 : ((u.pn >= 22) ? 2 : 0);
#pragma unroll
        for (int ai = 0; ai < 2; ++ai)
#pragma unroll
            for (int m = 0; m < 4; ++m) { bf16_t* rowp = O + (size_t)(row0 + ai * HALF + m * 16) * NIN + col0;
#pragma unroll
                for (int bj = 0; bj < 2; ++bj) { f32x4 v0 = acc[ai][bj][m][0], v1 = acc[ai][bj][m][1];
                    if (mode == 1) { v0 = v0 * QSCALE; v1 = v1 * QSCALE; }
                    if (mode == 2) {
#pragma unroll
                        for (int j = 0; j < 4; ++j) { v0[j] = fmaxf(sigmoidf_fast(v0[j]), 1e-30f); v1[j] = fmaxf(sigmoidf_fast(v1[j]), 1e-30f); } }
                    u32x4 w; w.x = cvt_pk_bf16(v0[0], v0[1]); w.y = cvt_pk_bf16(v0[2], v0[3]); w.z = cvt_pk_bf16(v1[0], v1[1]); w.w = cvt_pk_bf16(v1[2], v1[3]);
                    *(u32x4*)(rowp + bj * HALF) = w; } }
    }
};
struct EpiMix {
    static constexpr bool PERM = true, AFTER_DRAIN = false, SEG = true; static constexpr int T1 = 8, T2 = 24;
    bf16_t* O; const bf16_t* G;
    __device__ __forceinline__ void rescale(f32x4 (&acc)[2][2][4][2], const Unit& u, int t, int wr, int wc, int fr, int fq) const {
        const unsigned loff = (unsigned)(fr * NIN + 8 * fq) * 2u;
        const char* ub = (const char*)G + ((size_t)(u.pm * BM + wr * 64) * NIN + u.pn * BM + wc * 32 + (t == T1 ? 0 : D)) * 2;
#pragma unroll
        for (int ai = 0; ai < 2; ++ai)
#pragma unroll
            for (int m = 0; m < 4; ++m) { const char* gp = ub + (size_t)(ai * HALF + m * 16) * NIN * 2;
#pragma unroll
                for (int bj = 0; bj < 2; ++bj) { const u32x4 nu = *(const u32x4*)(gp + bj * HALF * 2 + loff), de = *(const u32x4*)(gp + (D + bj * HALF) * 2 + loff);
                    f32x4 r0, r1;
                    r0[0] = bf_lo(nu.x) * __builtin_amdgcn_rcpf(bf_lo(de.x)); r0[1] = bf_hi(nu.x) * __builtin_amdgcn_rcpf(bf_hi(de.x));
                    r0[2] = bf_lo(nu.y) * __builtin_amdgcn_rcpf(bf_lo(de.y)); r0[3] = bf_hi(nu.y) * __builtin_amdgcn_rcpf(bf_hi(de.y));
                    r1[0] = bf_lo(nu.z) * __builtin_amdgcn_rcpf(bf_lo(de.z)); r1[1] = bf_hi(nu.z) * __builtin_amdgcn_rcpf(bf_hi(de.z));
                    r1[2] = bf_lo(nu.w) * __builtin_amdgcn_rcpf(bf_lo(de.w)); r1[3] = bf_hi(nu.w) * __builtin_amdgcn_rcpf(bf_hi(de.w));
                    acc[ai][bj][m][0] = acc[ai][bj][m][0] * r0; acc[ai][bj][m][1] = acc[ai][bj][m][1] * r1; }
                if (m & 1) asm volatile("" ::: "memory"); }
    }
    __device__ __forceinline__ void operator()(const f32x4 (&acc)[2][2][4][2], const Unit& u, int wr, int wc, int fr, int fq) const {
        const int row0 = u.pm * BM + wr * 64 + fr, col0 = u.pn * BM + wc * 32 + 8 * fq;
#pragma unroll
        for (int ai = 0; ai < 2; ++ai)
#pragma unroll
            for (int m = 0; m < 4; ++m) { const size_t r = (size_t)(row0 + ai * HALF + m * 16); const bf16_t* gp = G + r * NIN + 2 * D + col0; bf16_t* rowp = O + r * D + col0;
#pragma unroll
                for (int bj = 0; bj < 2; ++bj) { const u32x4 g = *(const u32x4*)(gp + bj * HALF); f32x4 v0 = acc[ai][bj][m][0], v1 = acc[ai][bj][m][1];
                    v0[0] *= bf_lo(g.x); v0[1] *= bf_hi(g.x); v0[2] *= bf_lo(g.y); v0[3] *= bf_hi(g.y); v1[0] *= bf_lo(g.z); v1[1] *= bf_hi(g.z); v1[2] *= bf_lo(g.w); v1[3] *= bf_hi(g.w);
                    u32x4 w; w.x = cvt_pk_bf16(v0[0], v0[1]); w.y = cvt_pk_bf16(v0[2], v0[3]); w.z = cvt_pk_bf16(v1[0], v1[1]); w.w = cvt_pk_bf16(v1[2], v1[3]);
                    *(u32x4*)(rowp + bj * HALF) = w; }
                if (m & 1) asm volatile("" ::: "memory"); }
    }
};
struct EpiF32 {
    static constexpr bool PERM = false, AFTER_DRAIN = false, SEG = false; static constexpr int T1 = -1, T2 = -1;
    float* C; int ldc;
    __device__ __forceinline__ void rescale(f32x4 (&)[2][2][4][2], const Unit&, int, int, int, int, int) const {}
    __device__ __forceinline__ void operator()(const f32x4 (&acc)[2][2][4][2], const Unit& u, int wr, int wc, int fr, int fq) const {
        const int row0 = u.pm * BM + wr * 64 + fr, col0 = u.pn * BM + wc * 32 + 4 * fq;
#pragma unroll
        for (int ai = 0; ai < 2; ++ai)
#pragma unroll
            for (int m = 0; m < 4; ++m) { float* rowp = C + (size_t)(row0 + ai * HALF + m * 16) * ldc + col0;
#pragma unroll
                for (int bj = 0; bj < 2; ++bj)
#pragma unroll
                    for (int n = 0; n < 2; ++n) *(f32x4*)(rowp + bj * HALF + n * 16) = acc[ai][bj][m][n]; }
    }
};
struct EpiRelu2 {
    static constexpr bool PERM = true, AFTER_DRAIN = false, SEG = false; static constexpr int T1 = -1, T2 = -1;
    bf16_t* O; int ldc;
    __device__ __forceinline__ void rescale(f32x4 (&)[2][2][4][2], const Unit&, int, int, int, int, int) const {}
    __device__ __forceinline__ void operator()(const f32x4 (&acc)[2][2][4][2], const Unit& u, int wr, int wc, int fr, int fq) const {
        const int row0 = u.pm * BM + wr * 64 + fr, col0 = u.pn * BM + wc * 32 + 8 * fq;
#pragma unroll
        for (int ai = 0; ai < 2; ++ai)
#pragma unroll
            for (int m = 0; m < 4; ++m) { bf16_t* rowp = O + (size_t)(row0 + ai * HALF + m * 16) * ldc + col0;
#pragma unroll
                for (int bj = 0; bj < 2; ++bj) { f32x4 v0 = acc[ai][bj][m][0], v1 = acc[ai][bj][m][1];
#pragma unroll
                    for (int j = 0; j < 4; ++j) { const float a = fmaxf(v0[j], 0.f), b = fmaxf(v1[j], 0.f); v0[j] = a * a; v1[j] = b * b; }
                    u32x4 w; w.x = cvt_pk_bf16(v0[0], v0[1]); w.y = cvt_pk_bf16(v0[2], v0[3]); w.z = cvt_pk_bf16(v1[0], v1[1]); w.w = cvt_pk_bf16(v1[2], v1[3]);
                    *(u32x4*)(rowp + bj * HALF) = w; } }
    }
};

template <class Epi, class Sched, bool ALIGN_EPI = false, bool SP2 = false>
__device__ __forceinline__ void gemm_phase(PG8_LAS unsigned char* lds, const Gemm g, const Sched& S, const Epi& E) {
    int tid_ = threadIdx.x; asm volatile("" : "+v"(tid_));
    const int tid = tid_, wid = __builtin_amdgcn_readfirstlane(tid >> 6), lane = tid & 63, wr = wid >> 2, wc = wid & 3, fr = lane & 15, fq = lane >> 4;
    const int K = g.K, nt = K / BK;
    unsigned voffA[2], voffB[2];
#pragma unroll
    for (int i = 0; i < 2; ++i) { int R, C; stage_rc(tid * 16 + i * 8192, R, C); const int Rb = Epi::PERM ? ((R & ~31) + perm32(R & 31)) : R;
        voffA[i] = (unsigned)(R * K + C) * 2u; voffB[i] = (unsigned)(Rb * K + C) * 2u; }
    const size_t kstep = (size_t)(BK * 2);
    const size_t hstep = (size_t)HALF * K * 2;
    const size_t tstep = 2 * hstep;
    const unsigned ldsw = (unsigned)wid * 1024u;
    const int aoff = lds_byte(wr * 64 + fr, fq * 8), boff = lds_byte(wc * 32 + fr, fq * 8);
#define PG8_SA(b, h) (((b) * 2 + (h)) * HTB)
#define PG8_SB(b, h) ((4 + (b) * 2 + (h)) * HTB)
#define PG8_STAGE(bufoff, gbase, voff) do { _Pragma("unroll") for (int _i = 0; _i < 2; ++_i) \
        __builtin_amdgcn_global_load_lds((const unsigned*)((const char*)(gbase) + (voff)[_i]), (PG8_LAS unsigned*)(lds + (bufoff) + ldsw + _i * 8192), 16, 0, 0); } while (0)
#define PG8_LDA(dst, b, h) do { _Pragma("unroll") for (int m = 0; m < 4; ++m) _Pragma("unroll") for (int k = 0; k < 2; ++k) dst[m][k] = *(const PG8_LAS bf16x8*)(lds + PG8_SA(b, h) + aoff + m * 2048 + k * 1024); } while (0)
#define PG8_LDB(dst, b, h) do { _Pragma("unroll") for (int n = 0; n < 2; ++n) _Pragma("unroll") for (int k = 0; k < 2; ++k) dst[n][k] = *(const PG8_LAS bf16x8*)(lds + PG8_SB(b, h) + boff + n * 2048 + k * 1024); } while (0)
#define PG8_MMA(ai, bj, At, Bt) do { __builtin_amdgcn_s_setprio(1); _Pragma("unroll") for (int m = 0; m < 4; ++m) _Pragma("unroll") for (int n = 0; n < 2; ++n) _Pragma("unroll") for (int k = 0; k < 2; ++k) \
        acc[ai][bj][m][n] = __builtin_amdgcn_mfma_f32_16x16x32_bf16(Bt[n][k], At[m][k], acc[ai][bj][m][n], 0, 0, 0); __builtin_amdgcn_s_setprio(0); } while (0)
#define PG8_WAIT_V(n) asm volatile("s_waitcnt vmcnt(" #n ")" ::: "memory")
#define PG8_WAIT_L(n) asm volatile("s_waitcnt lgkmcnt(" #n ")" ::: "memory")
#define PG8_BAR __builtin_amdgcn_s_barrier()
#define PG8_SCHED __builtin_amdgcn_sched_barrier(0)
    Unit cur, nxt; int ui = 0;
    if (!S.next(0, cur)) return;
    f32x4 acc[2][2][4][2];
#pragma unroll
    for (int a = 0; a < 2; ++a)
#pragma unroll
        for (int b = 0; b < 2; ++b)
#pragma unroll
            for (int m = 0; m < 4; ++m)
#pragma unroll
                for (int n = 0; n < 2; ++n) acc[a][b][m][n] = (f32x4){0.f, 0.f, 0.f, 0.f};
    bf16x8 At[4][2], B0[2][2], B1[2][2];
    const char* cA = (const char*)g.A + (size_t)cur.pm * tstep; const char* cB = (const char*)g.Bt + (size_t)cur.pn * tstep;
    S.a_ready(cur);
    if constexpr (SP2) {
        PG8_STAGE(PG8_SB(0, 0), cB, voffB); PG8_STAGE(PG8_SB(0, 1), cB + hstep, voffB); PG8_STAGE(PG8_SA(0, 0), cA, voffA); PG8_STAGE(PG8_SA(0, 1), cA + hstep, voffA);
        if (wr == 1) PG8_BAR;
        PG8_WAIT_V(2); PG8_BAR;
        PG8_STAGE(PG8_SB(1, 0), cB + kstep, voffB); PG8_STAGE(PG8_SA(1, 0), cA + kstep, voffA); PG8_STAGE(PG8_SB(1, 1), cB + hstep + kstep, voffB);
        PG8_WAIT_V(6); PG8_BAR;
    } else {
        PG8_STAGE(PG8_SB(0, 0), cB, voffB); PG8_STAGE(PG8_SA(0, 0), cA, voffA); PG8_STAGE(PG8_SB(0, 1), cB + hstep, voffB); PG8_STAGE(PG8_SA(0, 1), cA + hstep, voffA);
        if (wr == 1) PG8_BAR;
        PG8_WAIT_V(4); PG8_BAR;
        PG8_STAGE(PG8_SB(1, 0), cB + kstep, voffB); PG8_STAGE(PG8_SA(1, 0), cA + kstep, voffA); PG8_STAGE(PG8_SB(1, 1), cB + hstep + kstep, voffB);
        PG8_WAIT_V(6); PG8_BAR;
    }
    for (;;) {
        const bool has_next = S.next(ui + 1, nxt);
        const char* nA = has_next ? (const char*)g.A + (size_t)nxt.pm * tstep : cA; const char* nB = has_next ? (const char*)g.Bt + (size_t)nxt.pn * tstep : cB;
        for (int t = 0; t < nt; t += 2) {
            const bool last = (t == nt - 2);
            if constexpr (Epi::SEG) { if (t == Epi::T1 || t == Epi::T2) E.rescale(acc, cur, t, wr, wc, fr, fq); }
            const char* a1 = cA + (size_t)(t + 1) * kstep;
            const char* a2 = last ? nA : cA + (size_t)(t + 2) * kstep; const char* b2 = last ? nB : cB + (size_t)(t + 2) * kstep;
            const char* a3 = a2 + kstep; const char* b3 = b2 + kstep;
            if (last && has_next) S.a_ready(nxt);
            if constexpr (SP2) {
            PG8_LDB(B0, 0, 0); PG8_LDB(B1, 0, 1); PG8_SCHED; PG8_LDA(At, 0, 0); PG8_STAGE(PG8_SA(1, 1), a1 + hstep, voffA);
            PG8_WAIT_V(8); PG8_WAIT_L(0); PG8_BAR; PG8_MMA(0, 0, At, B0); PG8_MMA(0, 1, At, B1); PG8_BAR; PG8_SCHED;
            PG8_LDA(At, 0, 1); PG8_STAGE(PG8_SB(0, 0), b2, voffB); PG8_STAGE(PG8_SB(0, 1), b2 + hstep, voffB); PG8_STAGE(PG8_SA(0, 0), a2, voffA);
            PG8_WAIT_V(8); PG8_WAIT_L(0); PG8_BAR; PG8_MMA(1, 0, At, B0); PG8_MMA(1, 1, At, B1); PG8_BAR; PG8_SCHED;
            PG8_LDB(B0, 1, 0); PG8_LDB(B1, 1, 1); PG8_SCHED; PG8_LDA(At, 1, 0); PG8_STAGE(PG8_SA(0, 1), a2 + hstep, voffA);
            PG8_WAIT_V(8); PG8_WAIT_L(0); PG8_BAR; PG8_MMA(0, 0, At, B0); PG8_MMA(0, 1, At, B1); PG8_BAR; PG8_SCHED;
            PG8_LDA(At, 1, 1); PG8_STAGE(PG8_SB(1, 0), b3, voffB); PG8_STAGE(PG8_SB(1, 1), b3 + hstep, voffB); PG8_STAGE(PG8_SA(1, 0), a3, voffA);
            PG8_WAIT_V(8); PG8_WAIT_L(0); PG8_BAR; PG8_MMA(1, 0, At, B0); PG8_MMA(1, 1, At, B1); PG8_BAR; PG8_SCHED;
            } else {
            PG8_LDB(B0, 0, 0); PG8_SCHED; PG8_LDA(At, 0, 0); PG8_STAGE(PG8_SA(1, 1), a1 + hstep, voffA);
            PG8_WAIT_L(8); PG8_BAR; PG8_WAIT_L(0); PG8_MMA(0, 0, At, B0); PG8_BAR; PG8_SCHED;
            PG8_LDB(B1, 0, 1); PG8_STAGE(PG8_SB(0, 0), b2, voffB);
            PG8_BAR; PG8_WAIT_L(0); PG8_MMA(0, 1, At, B1); PG8_BAR;
            PG8_LDA(At, 0, 1); PG8_STAGE(PG8_SA(0, 0), a2, voffA);
            PG8_BAR; PG8_WAIT_L(0); PG8_MMA(1, 0, At, B0); PG8_BAR; PG8_SCHED;
            PG8_STAGE(PG8_SB(0, 1), b2 + hstep, voffB);
            PG8_WAIT_V(6); PG8_BAR; PG8_MMA(1, 1, At, B1); PG8_BAR;
            PG8_LDB(B0, 1, 0); PG8_SCHED; PG8_LDA(At, 1, 0); PG8_STAGE(PG8_SA(0, 1), a2 + hstep, voffA);
            PG8_WAIT_L(8); PG8_BAR; PG8_WAIT_L(0); PG8_MMA(0, 0, At, B0); PG8_BAR; PG8_SCHED;
            PG8_LDB(B1, 1, 1); PG8_STAGE(PG8_SB(1, 0), b3, voffB);
            PG8_BAR; PG8_WAIT_L(0); PG8_MMA(0, 1, At, B1); PG8_BAR;
            PG8_LDA(At, 1, 1); PG8_STAGE(PG8_SA(1, 0), a3, voffA);
            PG8_BAR; PG8_WAIT_L(0); PG8_MMA(1, 0, At, B0); PG8_BAR; PG8_SCHED;
            PG8_STAGE(PG8_SB(1, 1), b3 + hstep, voffB);
            PG8_WAIT_V(6); PG8_BAR; PG8_MMA(1, 1, At, B1); PG8_BAR;
            }
        }
        if constexpr (ALIGN_EPI) { if (wr == 0) PG8_BAR; }
        E(acc, cur, wr, wc, fr, fq); S.done(cur);
        if (!has_next) break;
#pragma unroll
        for (int a = 0; a < 2; ++a)
#pragma unroll
            for (int b = 0; b < 2; ++b)
#pragma unroll
                for (int m = 0; m < 4; ++m)
#pragma unroll
                    for (int n = 0; n < 2; ++n) acc[a][b][m][n] = (f32x4){0.f, 0.f, 0.f, 0.f};
        cur = nxt; cA = nA; cB = nB; ++ui;
        if constexpr (ALIGN_EPI) { if (wr == 1) PG8_BAR; }
    }
    PG8_WAIT_V(0);
    if constexpr (!ALIGN_EPI) { if (wr == 0) PG8_BAR; }
    PG8_BAR;
#undef PG8_SA
#undef PG8_SB
#undef PG8_STAGE
#undef PG8_LDA
#undef PG8_LDB
#undef PG8_MMA
#undef PG8_WAIT_V
#undef PG8_WAIT_L
#undef PG8_BAR
#undef PG8_SCHED
}
}

constexpr int NWAVES = 8;
constexpr size_t MiB = 1u << 20;
constexpr size_t WS_CTL = 0, CTL_ZERO_BYTES = 1 * MiB;
constexpr size_t WL_IN = 0, WL_PABC = 46 * MiB, WL_O = 54 * MiB, WL_UP = 62 * MiB, WL_DOWN = 94 * MiB, WL_STRIDE = 126 * MiB;
constexpr size_t WS_W = 1 * MiB;
constexpr size_t WS_H = WS_W + DEPTH * WL_STRIDE;
constexpr size_t WS_PROJ = WS_H + 32 * MiB;
constexpr size_t WS_Z = WS_PROJ + 184 * MiB;
constexpr size_t WS_MIX = WS_Z + 32 * MiB;
constexpr size_t WS_Y = WS_MIX + 32 * MiB;
constexpr size_t WS_F = WS_Y + 64 * MiB;
constexpr size_t WS_END = WS_F + 128 * MiB;
static_assert((size_t)NIN * D * 2 == 46 * MiB && (size_t)M * NIN * 2 == 184 * MiB, "map");
constexpr int CW_TMO = 0, CW_CODE = 1, CW_BAR = 4096;

constexpr int RING_OFF = 0, PHASE_LDS = 143360;
constexpr int LDSCTL_OFF = PHASE_LDS, MISC_OFF = LDSCTL_OFF + 320, LDS_BYTES = 147456;

#define GAS __attribute__((address_space(1)))
#define LAS __attribute__((address_space(3)))
typedef unsigned short bf16;
typedef unsigned v4u __attribute__((ext_vector_type(4)));
typedef unsigned v2u __attribute__((ext_vector_type(2)));
typedef float f32x4 __attribute__((ext_vector_type(4)));
typedef GAS unsigned gu32;
#define RLX_AGENT __ATOMIC_RELAXED, __HIP_MEMORY_SCOPE_AGENT
#define LDS_WAIT() asm volatile("s_waitcnt lgkmcnt(0)" ::: "memory")
#define VM_WAIT() asm volatile("s_waitcnt vmcnt(0)" ::: "memory")
using pg8::cvt_pk_bf16; using pg8::bf_lo; using pg8::bf_hi;

#define XB_TMO      128
#define XB_XCNT(j)  (256  + 64 * (j))
#define XB_XSUB(j)  (1280 + 64 * (j))
#define XB_XGEN(j)  (2304 + 64 * (j))
#define XB_TOP      3328
#define XB_TOPGEN   3392
#define XCD_BAR_WORDS 3456
#define XB_SPIN_CAP (1u << 18)
__device__ __forceinline__ unsigned xb_ld(unsigned* p)              { return __hip_atomic_load(p, __ATOMIC_RELAXED, __HIP_MEMORY_SCOPE_AGENT); }
__device__ __forceinline__ unsigned xb_add(unsigned* p, unsigned v) { return __hip_atomic_fetch_add(p, v, __ATOMIC_RELAXED, __HIP_MEMORY_SCOPE_AGENT); }
__device__ __forceinline__ unsigned xb_xcc_id() { return (unsigned)__builtin_amdgcn_s_getreg((3 << 11) | 20) & 0xFu; }
#define XB_SPIN(cond, bar) do { unsigned _sp = 0; while (cond) { __builtin_amdgcn_s_sleep(1); \
    if ((++_sp & 255u) == 0u) { if (xb_ld(&(bar)[XB_TMO])) break; if (_sp > XB_SPIN_CAP) { atomicAdd(&(bar)[XB_TMO], 1u); break; } } } } while (0)
struct XcdBarrier { unsigned* bar; unsigned x; volatile LAS unsigned* st; };
__device__ __forceinline__ XcdBarrier xcd_barrier_post(unsigned* bar, volatile LAS unsigned* st) {
    XcdBarrier b; b.bar = bar; b.x = xb_xcc_id(); b.st = st;
    if (threadIdx.x == 0) (void)xb_add(&bar[XB_XCNT(b.x)], 1u);
    return b;
}
__device__ __forceinline__ void xcd_barrier_complete(unsigned* bar, unsigned x, unsigned& nloc, unsigned& nx) {
    const unsigned G = gridDim.x * gridDim.y * gridDim.z;
    unsigned sum, cnt, mine, sp = 0u;
    for (;;) {
        sum = 0u; cnt = 0u; mine = 0u;
#pragma unroll
        for (unsigned j = 0; j < 16; ++j) { const unsigned c = xb_ld(&bar[XB_XCNT(j)]); sum += c; cnt += (c > 0u) ? 1u : 0u; mine = (j == x) ? c : mine; }
        if (sum == G) break;
        __builtin_amdgcn_s_sleep(1);
        if ((++sp & 255u) == 0u) { if (xb_ld(&bar[XB_TMO])) break; if (sp > XB_SPIN_CAP) { atomicAdd(&bar[XB_TMO], 1u); break; } }
    }
    nloc = mine > 0u ? mine : 1u; nx = cnt > 0u ? cnt : 1u;
}
__device__ __forceinline__ void xcd_barrier(const XcdBarrier& b) {
    asm volatile("s_waitcnt vmcnt(0)" ::: "memory");
    __syncthreads();
    if (threadIdx.x == 0) {
        unsigned* bar = b.bar;
        __builtin_amdgcn_s_waitcnt(0);
        unsigned nloc = b.st[0], nx = b.st[1];
        if (nloc == 0u) { xcd_barrier_complete(bar, b.x, nloc, nx); b.st[0] = nloc; b.st[1] = nx; }
        const unsigned old = xb_add(&bar[XB_XSUB(b.x)], 1u);
        const unsigned gen = old / nloc;
        if (old + 1u == (gen + 1u) * nloc) {
            __builtin_amdgcn_fence(__ATOMIC_RELEASE, "agent");
            asm volatile("s_waitcnt vmcnt(0)" ::: "memory");
            const unsigned og = xb_add(&bar[XB_TOP], 1u);
            const unsigned tg = og / nx;
            if (og + 1u == (tg + 1u) * nx) xb_add(&bar[XB_TOPGEN], 1u);
            else XB_SPIN(xb_ld(&bar[XB_TOPGEN]) == tg, bar);
            __builtin_amdgcn_fence(__ATOMIC_ACQUIRE, "agent");
            xb_add(&bar[XB_XGEN(b.x)], 1u);
            asm volatile("s_waitcnt vmcnt(0)" ::: "memory");
        } else {
            XB_SPIN(xb_ld(&bar[XB_XGEN(b.x)]) == gen, bar);
            __builtin_amdgcn_fence(__ATOMIC_ACQUIRE, "agent");
            asm volatile("s_waitcnt vmcnt(0)" ::: "memory");
        }
    }
    __syncthreads();
}

struct Frame {
    LAS unsigned char* lds;
    int vcu, G;
    const float *x, *ln_mix_pre, *ln_mix_post, *ln_mlp_pre, *ln_mlp_post, *w_in, *conv_a_w, *proj_a, *proj_b, *conv_c_w, *conv_c_b, *norm_c_g, *norm_c_b, *proj_c, *w_o, *w_up, *w_down;
    float* out;
    unsigned char* ws;
    bf16 *H, *PROJ, *Z, *MIX, *F; float* Y;
};
__device__ __forceinline__ bf16* wl(const Frame& F, int l, size_t off) { return (bf16*)(F.ws + WS_W + (size_t)l * WL_STRIDE + off); }

__device__ __forceinline__ int fresh_tid() { int t = threadIdx.x; asm volatile("" : "+v"(t)); return t; }
__device__ __forceinline__ float wave_sum(float v) {
#pragma unroll
    for (int o = 1; o < 64; o <<= 1) v += __shfl_xor(v, o);
    return v;
}

__device__ __forceinline__ void transpose_item(const float* __restrict__ W, int N, bf16* __restrict__ WT, int ldk, int koff, int kb, int nb, LAS float* scr, int lane) {
    const int k0 = kb * 64, n0 = nb * 64, kr = lane >> 4, n4 = lane & 15;
    f32x4 v[16];
#pragma unroll
    for (int i = 0; i < 16; ++i) v[i] = *(const GAS f32x4*)(W + (size_t)(k0 + 4 * i + kr) * N + n0 + 4 * n4);
#pragma unroll
    for (int i = 0; i < 16; ++i) { LAS float* s = scr + (4 * i + kr) * 65 + 4 * n4; s[0] = v[i].x; s[1] = v[i].y; s[2] = v[i].z; s[3] = v[i].w; }
    LDS_WAIT(); asm volatile("" ::: "memory");
    const int kc = lane >> 3, nr = lane & 7;
#pragma unroll
    for (int j = 0; j < 8; ++j) { const int n = 8 * j + nr; const LAS float* s = scr + (8 * kc) * 65 + n;
        v4u o; o.x = cvt_pk_bf16(s[0 * 65], s[1 * 65]); o.y = cvt_pk_bf16(s[2 * 65], s[3 * 65]); o.z = cvt_pk_bf16(s[4 * 65], s[5 * 65]); o.w = cvt_pk_bf16(s[6 * 65], s[7 * 65]);
        *(GAS v4u*)(WT + (size_t)(n0 + n) * ldk + koff + k0 + 8 * kc) = o; }
    LDS_WAIT(); asm volatile("" ::: "memory");
}
__device__ __forceinline__ void rms_row_to_bf16(const float* xrow, const float* gain, bf16* orow, int lane) {
    const GAS f32x4* xr = (const GAS f32x4*)xrow + lane; const GAS f32x4* gr = (const GAS f32x4*)gain + lane;
    f32x4 v[8]; float s = 0.f;
#pragma unroll
    for (int j = 0; j < 8; ++j) { v[j] = xr[64 * j]; s += (v[j].x * v[j].x + v[j].y * v[j].y) + (v[j].z * v[j].z + v[j].w * v[j].w); }
    const float r = 1.0f / sqrtf(wave_sum(s) * (1.f / D) + RMS_EPS);
    GAS v2u* o8 = (GAS v2u*)orow + lane;
#pragma unroll
    for (int j = 0; j < 8; ++j) { const f32x4 g = gr[64 * j]; v2u o; o.x = cvt_pk_bf16(v[j].x * r * g.x, v[j].y * r * g.y); o.y = cvt_pk_bf16(v[j].z * r * g.z, v[j].w * r * g.w); o8[64 * j] = o; }
}
__device__ __forceinline__ void p0_prologue(Frame& F) {
    const int tid = fresh_tid(), lane = tid & 63, wave = __builtin_amdgcn_readfirstlane(tid >> 6);
    LAS float* scr = (LAS float*)(F.lds + RING_OFF) + wave * (64 * 65);
    const int gw = F.vcu * NWAVES + wave, NGW = F.G * NWAVES;
    constexpr int I_IN = (D / 64) * (NIN / 64), I_A = (DSC / 64) * (D / 64), I_B = (DATT / 64) * (D / 64), I_C = (DCF / 64) * (D / 64), I_O = (D / 64) * (D / 64), I_UP = (D / 64) * (DFF / 64), I_DN = (DFF / 64) * (D / 64);
    constexpr int PER_L = I_IN + I_A + I_B + I_C + I_O + I_UP + I_DN;
    for (int it = gw; it < DEPTH * PER_L; it += NGW) {
        const int l = it / PER_L; int r = it - l * PER_L;
        if (r < I_IN) { transpose_item(F.w_in + (size_t)l * D * NIN, NIN, wl(F, l, WL_IN), D, 0, r / (NIN / 64), r % (NIN / 64), scr, lane); continue; } r -= I_IN;
        if (r < I_A)  { transpose_item(F.proj_a + (size_t)l * DSC * D, D, wl(F, l, WL_PABC), D, Z_A, r / (D / 64), r % (D / 64), scr, lane); continue; } r -= I_A;
        if (r < I_B)  { transpose_item(F.proj_b + (size_t)l * DATT * D, D, wl(F, l, WL_PABC), D, Z_B, r / (D / 64), r % (D / 64), scr, lane); continue; } r -= I_B;
        if (r < I_C)  { transpose_item(F.proj_c + (size_t)l * DCF * D, D, wl(F, l, WL_PABC), D, Z_C, r / (D / 64), r % (D / 64), scr, lane); continue; } r -= I_C;
        if (r < I_O)  { transpose_item(F.w_o + (size_t)l * D * D, D, wl(F, l, WL_O), D, 0, r / (D / 64), r % (D / 64), scr, lane); continue; } r -= I_O;
        if (r < I_UP) { transpose_item(F.w_up + (size_t)l * D * DFF, DFF, wl(F, l, WL_UP), D, 0, r / (DFF / 64), r % (DFF / 64), scr, lane); continue; } r -= I_UP;
        transpose_item(F.w_down + (size_t)l * DFF * D, D, wl(F, l, WL_DOWN), DFF, 0, r / (D / 64), r % (D / 64), scr, lane);
    }
    for (int m = gw; m < M; m += NGW) rms_row_to_bf16(F.x + (size_t)m * D, F.ln_mix_pre, F.H + (size_t)m * D, lane);
}

__device__ __forceinline__ void norm_phase(Frame& F, const float* xprev, const float* g_post, const float* g_next) {
    const int tid = fresh_tid(), lane = tid & 63, wave = __builtin_amdgcn_readfirstlane(tid >> 6);
    const int gw = F.vcu * NWAVES + wave, NGW = F.G * NWAVES;
    for (int m = gw; m < M; m += NGW) {
        const GAS f32x4* yr = (const GAS f32x4*)(F.Y + (size_t)m * D) + lane; const GAS f32x4* xr = (const GAS f32x4*)(xprev + (size_t)m * D) + lane;
        const GAS f32x4* gp = (const GAS f32x4*)g_post + lane; GAS f32x4* xo = (GAS f32x4*)(F.out + (size_t)m * D) + lane;
        f32x4 y[8], x[8]; float s = 0.f;
#pragma unroll
        for (int j = 0; j < 8; ++j) { y[j] = yr[64 * j]; x[j] = xr[64 * j]; }
#pragma unroll
        for (int j = 0; j < 8; ++j) s += (y[j].x * y[j].x + y[j].y * y[j].y) + (y[j].z * y[j].z + y[j].w * y[j].w);
        const float r1 = 1.0f / sqrtf(wave_sum(s) * (1.f / D) + RMS_EPS);
        float s2 = 0.f;
#pragma unroll
        for (int j = 0; j < 8; ++j) { const f32x4 g = gp[64 * j]; x[j] = x[j] + (y[j] * r1) * g; xo[64 * j] = x[j]; s2 += (x[j].x * x[j].x + x[j].y * x[j].y) + (x[j].z * x[j].z + x[j].w * x[j].w); }
        if (g_next) {
            const float r2 = 1.0f / sqrtf(wave_sum(s2) * (1.f / D) + RMS_EPS);
            const GAS f32x4* gn = (const GAS f32x4*)g_next + lane; GAS v2u* o8 = (GAS v2u*)(F.H + (size_t)m * D) + lane;
#pragma unroll
            for (int j = 0; j < 8; ++j) { const f32x4 g = gn[64 * j]; v2u o; o.x = cvt_pk_bf16(x[j].x * r2 * g.x, x[j].y * r2 * g.y); o.y = cvt_pk_bf16(x[j].z * r2 * g.z, x[j].w * r2 * g.w); o8[64 * j] = o; }
        }
    }
}

__device__ __forceinline__ void unpack8(const v4u w, float (&f)[8]) { f[0] = bf_lo(w.x); f[1] = bf_hi(w.x); f[2] = bf_lo(w.y); f[3] = bf_hi(w.y); f[4] = bf_lo(w.z); f[5] = bf_hi(w.z); f[6] = bf_lo(w.w); f[7] = bf_hi(w.w); }
__device__ __forceinline__ v4u pack8(const float (&f)[8]) { v4u o; o.x = cvt_pk_bf16(f[0], f[1]); o.y = cvt_pk_bf16(f[2], f[3]); o.z = cvt_pk_bf16(f[4], f[5]); o.w = cvt_pk_bf16(f[6], f[7]); return o; }
__device__ __forceinline__ void conv_item(Frame& F, int l, int item) {
    const int b = item >> 6, t0 = (item & 63) * 32, rowbase = b * SEQ, tid = fresh_tid(), lane = tid & 63, wave = __builtin_amdgcn_readfirstlane(tid >> 6);
    LAS float* U = (LAS float*)(F.lds + RING_OFF);
    for (int idx = tid; idx < 62 * 64; idx += NWAVES * 64) {
        const int rr = idx >> 6, c8 = (idx & 63) * 8, t = t0 - 30 + rr; float u[8];
        if (t >= 0) { const bf16* p = F.PROJ + (size_t)(rowbase + t) * NIN + c8; float a[8], g[8]; unpack8(*(const GAS v4u*)(p + C_CA), a); unpack8(*(const GAS v4u*)(p + C_CG), g);
#pragma unroll
            for (int j = 0; j < 8; ++j) u[j] = a[j] * pg8::sigmoidf_fast(g[j]); }
        else {
#pragma unroll
            for (int j = 0; j < 8; ++j) u[j] = 0.f; }
        LAS f32x4* d = (LAS f32x4*)(U + rr * 512 + c8); d[0] = (f32x4){u[0], u[1], u[2], u[3]}; d[1] = (f32x4){u[4], u[5], u[6], u[7]};
    }
    __syncthreads();
    const int c8 = lane * 8;
    {
        float acc[4][8];
        { const GAS f32x4* bp = (const GAS f32x4*)(F.conv_c_b + (size_t)l * DCF + c8); const f32x4 b0 = bp[0], b1 = bp[1];
#pragma unroll
          for (int j = 0; j < 4; ++j) { acc[j][0] = b0.x; acc[j][1] = b0.y; acc[j][2] = b0.z; acc[j][3] = b0.w; acc[j][4] = b1.x; acc[j][5] = b1.y; acc[j][6] = b1.z; acc[j][7] = b1.w; } }
        const float* wbase = F.conv_c_w + (size_t)l * CFW * DCF + c8;
#pragma unroll 1
        for (int k = 0; k < CFW; ++k) {
            const GAS f32x4* wp = (const GAS f32x4*)(wbase + (size_t)k * DCF); const f32x4 w0 = wp[0], w1 = wp[1];
#pragma unroll
            for (int j = 0; j < 4; ++j) { const LAS f32x4* up = (const LAS f32x4*)(U + (4 * wave + j + k) * 512 + c8); const f32x4 u0 = up[0], u1 = up[1];
                acc[j][0] += w0.x * u0.x; acc[j][1] += w0.y * u0.y; acc[j][2] += w0.z * u0.z; acc[j][3] += w0.w * u0.w;
                acc[j][4] += w1.x * u1.x; acc[j][5] += w1.y * u1.y; acc[j][6] += w1.z * u1.z; acc[j][7] += w1.w * u1.w; }
        }
        const GAS f32x4* gp = (const GAS f32x4*)(F.norm_c_g + (size_t)l * DCF + c8); const GAS f32x4* bp = (const GAS f32x4*)(F.norm_c_b + (size_t)l * DCF + c8);
        const f32x4 g0 = gp[0], g1 = gp[1], e0 = bp[0], e1 = bp[1];
        const float gg[8] = {g0.x, g0.y, g0.z, g0.w, g1.x, g1.y, g1.z, g1.w}, ee[8] = {e0.x, e0.y, e0.z, e0.w, e1.x, e1.y, e1.z, e1.w};
#pragma unroll
        for (int j = 0; j < 4; ++j) {
            float s = 0.f;
#pragma unroll
            for (int q = 0; q < 8; ++q) s += acc[j][q];
            const float mean = wave_sum(s) * (1.f / DCF); float qq = 0.f;
#pragma unroll
            for (int q = 0; q < 8; ++q) { acc[j][q] -= mean; qq += acc[j][q] * acc[j][q]; }
            const float rstd = 1.0f / sqrtf(wave_sum(qq) * (1.f / DCF) + LN_EPS); float o[8];
#pragma unroll
            for (int q = 0; q < 8; ++q) { const float y = acc[j][q] * rstd * gg[q] + ee[q]; o[q] = y * pg8::sigmoidf_fast(y); }
            *(GAS v4u*)(F.Z + (size_t)(rowbase + t0 + 4 * wave + j) * D + Z_C + c8) = pack8(o);
        }
    }
    {
        const GAS f32x4* wp = (const GAS f32x4*)(F.conv_a_w + (size_t)l * SCW * DSC + c8);
        float w[3][8];
#pragma unroll
        for (int k = 0; k < 3; ++k) { const f32x4 a = wp[k * (DSC / 4)], c = wp[k * (DSC / 4) + 1]; w[k][0] = a.x; w[k][1] = a.y; w[k][2] = a.z; w[k][3] = a.w; w[k][4] = c.x; w[k][5] = c.y; w[k][6] = c.z; w[k][7] = c.w; }
#pragma unroll
        for (int j = 0; j < 4; ++j) { const int t = t0 + 4 * wave + j; float o[8];
#pragma unroll
            for (int q = 0; q < 8; ++q) o[q] = 0.f;
#pragma unroll
            for (int k = 0; k < 3; ++k) { const int ts = t - 2 + k;
                if (ts >= 0) { const bf16* p = F.PROJ + (size_t)(rowbase + ts) * NIN + c8; float cc[8], uu[8]; unpack8(*(const GAS v4u*)(p + C_SC), cc); unpack8(*(const GAS v4u*)(p + C_SU), uu);
#pragma unroll
                    for (int q = 0; q < 8; ++q) o[q] += w[k][q] * (cc[q] * uu[q]); } }
            float bb[8]; unpack8(*(const GAS v4u*)(F.PROJ + (size_t)(rowbase + t) * NIN + C_SB + c8), bb);
#pragma unroll
            for (int q = 0; q < 8; ++q) o[q] *= bb[q];
            *(GAS v4u*)(F.Z + (size_t)(rowbase + t) * D + Z_A + c8) = pack8(o);
        }
    }
    __syncthreads();
}

__device__ __forceinline__ void attn_simple_item(Frame& F, int id) {
    const int lane = fresh_tid() & 63, bh = id >> 6, jj = id & 63, qc = (jj & 1) ? 63 - (jj >> 1) : (jj >> 1);
    const int b = bh >> 3, h = bh & 7, qi = lane & 31, half = lane >> 5, t = qc * 32 + qi;
    const bf16* base = F.PROJ + (size_t)(b * SEQ) * NIN + h * HD + half * 64;
    float q[64], o[64];
    { const GAS v4u* qp = (const GAS v4u*)(base + (size_t)t * NIN + C_Q);
#pragma unroll
      for (int i = 0; i < 8; ++i) { float f[8]; unpack8(qp[i], f);
#pragma unroll
          for (int j = 0; j < 8; ++j) q[8 * i + j] = f[j]; } }
#pragma unroll
    for (int i = 0; i < 64; ++i) o[i] = 0.f;
    float carry = 1.f;
#pragma unroll 1
    for (int s = qc * 32 + 30; s >= 0; --s) {
        const GAS v4u* kp = (const GAS v4u*)(base + (size_t)s * NIN + C_K); const GAS v4u* vp = (const GAS v4u*)(base + (size_t)s * NIN + C_V);
        float z0 = 0.f, z1 = 0.f;
#pragma unroll
        for (int i = 0; i < 8; ++i) { float f[8]; unpack8(kp[i], f);
#pragma unroll
            for (int j = 0; j < 8; j += 2) { z0 += q[8 * i + j] * f[j]; z1 += q[8 * i + j + 1] * f[j + 1]; } }
        float z = z0 + z1; z += __shfl_xor(z, 32);
        const float e = __builtin_amdgcn_exp2f(fminf(-z, 100.f)), sg = __builtin_amdgcn_rcpf(1.f + e);
        const bool act = s < t;
        const float a = act ? sg * carry : 0.f;
        carry = act ? carry * (e * sg) : carry;
#pragma unroll
        for (int i = 0; i < 8; ++i) { float f[8]; unpack8(vp[i], f);
#pragma unroll
            for (int j = 0; j < 8; ++j) o[8 * i + j] += a * f[j]; }
    }
    GAS v4u* op = (GAS v4u*)(F.Z + (size_t)(b * SEQ + t) * D + Z_B + h * HD + half * 64);
#pragma unroll
    for (int i = 0; i < 8; ++i) { float f[8];
#pragma unroll
        for (int j = 0; j < 8; ++j) f[j] = o[8 * i + j];
        op[i] = pack8(f); }
}

struct Args { const float* in[17]; float* out; unsigned char* ws; int l_lo, l_hi, ph_lo, ph_hi; };
constexpr int NPH = 9;
__global__ void __launch_bounds__(NWAVES * 64, 2) mega_fwd(Args args) {
    extern __shared__ __attribute__((aligned(16))) unsigned char lds[];
    Frame F;
    F.lds = (LAS unsigned char*)lds;
    F.G = gridDim.x; { const int bx = blockIdx.x; F.vcu = (F.G % 8 == 0) ? (bx % 8) * (F.G / 8) + bx / 8 : bx; }
    F.x = args.in[0]; F.ln_mix_pre = args.in[1]; F.ln_mix_post = args.in[2]; F.ln_mlp_pre = args.in[3]; F.ln_mlp_post = args.in[4]; F.w_in = args.in[5]; F.conv_a_w = args.in[6];
    F.proj_a = args.in[7]; F.proj_b = args.in[8]; F.conv_c_w = args.in[9]; F.conv_c_b = args.in[10]; F.norm_c_g = args.in[11]; F.norm_c_b = args.in[12]; F.proj_c = args.in[13];
    F.w_o = args.in[14]; F.w_up = args.in[15]; F.w_down = args.in[16]; F.out = args.out; F.ws = args.ws;
    F.H = (bf16*)(F.ws + WS_H); F.PROJ = (bf16*)(F.ws + WS_PROJ); F.Z = (bf16*)(F.ws + WS_Z); F.MIX = (bf16*)(F.ws + WS_MIX); F.F = (bf16*)(F.ws + WS_F); F.Y = (float*)(F.ws + WS_Y);
    gu32* ctl = (gu32*)(F.ws + WS_CTL);
    for (int u = threadIdx.x; u < (LDS_BYTES - LDSCTL_OFF) / 4; u += NWAVES * 64) ((LAS unsigned*)(F.lds + LDSCTL_OFF))[u] = 0u;
    __syncthreads();
#if MK_MULTI
#define SEAM() do { } while (0)
#else
    XcdBarrier bar = xcd_barrier_post((unsigned*)(ctl + CW_BAR), (volatile LAS unsigned*)(F.lds + MISC_OFF) + 8);
#define SEAM() xcd_barrier(bar)
#endif
    const int lo = args.ph_lo, hi = args.ph_hi;
#define IN(k) (lo <= (k) && (k) < hi)
    for (int l = args.l_lo; l < args.l_hi; ++l) {
        if (l == 0 && IN(0)) {
#if !MK_SKEL && ((PH_MASK >> 0) & 1)
            p0_prologue(F);
#endif
            SEAM();
        }
        if (IN(1)) {
#if !MK_SKEL && ((PH_MASK >> 1) & 1)
            pg8::Gemm g{F.H, wl(F, l, WL_IN), M, NIN, D}; pg8::StaticOrder S; S.init(M, NIN, F.G, (int)blockIdx.x);
            pg8::EpiIn E{F.PROJ};
            pg8::gemm_phase<pg8::EpiIn, pg8::StaticOrder, true, true>(F.lds + RING_OFF, g, S, E);
#endif
            SEAM();
        }
        if (IN(2)) {
#if !MK_SKEL && ((PH_MASK >> 2) & 1)
            for (int it = F.vcu; it < BATCH * (SEQ / 32); it += F.G) conv_item(F, l, it);
            for (int id = F.vcu * NWAVES + __builtin_amdgcn_readfirstlane(fresh_tid() >> 6); id < BATCH * NHEAD * (SEQ / 32); id += F.G * NWAVES) attn_simple_item(F, id);
#endif
            SEAM();
        }
        if (IN(3)) {
#if !MK_SKEL && ((PH_MASK >> 3) & 1)
            pg8::Gemm g{F.Z, wl(F, l, WL_PABC), M, D, D}; pg8::StaticOrder S; S.init(M, D, F.G, (int)blockIdx.x);
            pg8::EpiMix E{F.MIX, F.PROJ + C_G};
            pg8::gemm_phase<pg8::EpiMix, pg8::StaticOrder, true, true>(F.lds + RING_OFF, g, S, E);
#endif
            SEAM();
        }
        if (IN(4)) {
#if !MK_SKEL && ((PH_MASK >> 4) & 1)
            pg8::Gemm g{F.MIX, wl(F, l, WL_O), M, D, D}; pg8::StaticOrder S; S.init(M, D, F.G, (int)blockIdx.x);
            pg8::EpiF32 E{F.Y, D};
            pg8::gemm_phase<pg8::EpiF32, pg8::StaticOrder, true, true>(F.lds + RING_OFF, g, S, E);
#endif
            SEAM();
        }
        if (IN(5)) {
#if !MK_SKEL && ((PH_MASK >> 5) & 1)
            norm_phase(F, l == 0 ? F.x : F.out, F.ln_mix_post + (size_t)l * D, F.ln_mlp_pre + (size_t)l * D);
#endif
            SEAM();
        }
        if (IN(6)) {
#if !MK_SKEL && ((PH_MASK >> 6) & 1)
            pg8::Gemm g{F.H, wl(F, l, WL_UP), M, DFF, D}; pg8::StaticOrder S; S.init(M, DFF, F.G, (int)blockIdx.x);
            pg8::EpiRelu2 E{F.F, DFF};
            pg8::gemm_phase<pg8::EpiRelu2, pg8::StaticOrder, true, true>(F.lds + RING_OFF, g, S, E);
#endif
            SEAM();
        }
        if (IN(7)) {
#if !MK_SKEL && ((PH_MASK >> 7) & 1)
            pg8::Gemm g{F.F, wl(F, l, WL_DOWN), M, D, DFF}; pg8::StaticOrder S; S.init(M, D, F.G, (int)blockIdx.x);
            pg8::EpiF32 E{F.Y, D};
            pg8::gemm_phase<pg8::EpiF32, pg8::StaticOrder, true, true>(F.lds + RING_OFF, g, S, E);
#endif
            SEAM();
        }
        if (IN(8)) {
#if !MK_SKEL && ((PH_MASK >> 8) & 1)
            norm_phase(F, F.out, F.ln_mlp_post + (size_t)l * D, (l + 1 < DEPTH) ? F.ln_mix_pre + (size_t)(l + 1) * D : nullptr);
#endif
            if (l + 1 < DEPTH) SEAM();
        }
    }
#undef IN
}

extern "C" void kernel_launch(void* const* d_in, const int* in_sizes, int n_in, void* d_out, int out_size, void* d_ws, size_t ws_size, hipStream_t stream) {
    static int grid = 0;
    if (grid == 0) {
        if (n_in != 17 || in_sizes[0] != M * D || out_size != M * D || ws_size < WS_END) { fprintf(stderr, "kernel_launch: unexpected shapes (n_in %d, in0 %d, out %d, ws %zu < %zu)\n", n_in, n_in > 0 ? in_sizes[0] : -1, out_size, ws_size, (size_t)WS_END); grid = -1; return; }
        int dev = 0, cus = 0, per_cu = 0;
        if (hipGetDevice(&dev) != hipSuccess || hipDeviceGetAttribute(&cus, hipDeviceAttributeMultiprocessorCount, dev) != hipSuccess) { grid = -1; return; }
        if (hipFuncSetAttribute((const void*)mega_fwd, hipFuncAttributeMaxDynamicSharedMemorySize, LDS_BYTES) != hipSuccess) { fprintf(stderr, "kernel_launch: hipFuncSetAttribute failed\n"); grid = -1; return; }
        if (hipOccupancyMaxActiveBlocksPerMultiprocessor(&per_cu, (const void*)mega_fwd, NWAVES * 64, LDS_BYTES) != hipSuccess || per_cu < 1) { fprintf(stderr, "kernel_launch: occupancy query says %d\n", per_cu); (void)hipGetLastError(); per_cu = 1; }
        grid = cus;
    }
    if (grid < 0) return;
    if (hipMemsetAsync((char*)d_ws + WS_CTL, 0, CTL_ZERO_BYTES, stream) != hipSuccess) return;
    Args a{};
    for (int i = 0; i < 17; ++i) a.in[i] = (const float*)d_in[i];
    a.out = (float*)d_out; a.ws = (unsigned char*)d_ws;
#if MK_MULTI
    for (int l = 0; l < DEPTH; ++l)
        for (int p = (l == 0 ? 0 : 1); p < NPH; ++p) { a.l_lo = l; a.l_hi = l + 1; a.ph_lo = p; a.ph_hi = p + 1; hipLaunchKernelGGL(mega_fwd, dim3(grid), dim3(NWAVES * 64), LDS_BYTES, stream, a); }
#else
    a.l_lo = 0; a.l_hi = DEPTH; a.ph_lo = 0; a.ph_hi = NPH;
    hipLaunchKernelGGL(mega_fwd, dim3(grid), dim3(NWAVES * 64), LDS_BYTES, stream, a);
#endif
}
```

```cpp
#include <hip/hip_runtime.h>
#include <cstdio>
#include <cstdint>

#ifndef MK_MULTI
#define MK_MULTI 0
#endif
#ifndef PH_MASK
#define PH_MASK 0x1ff
#endif
#ifndef ATTN_SIMPLE
#define ATTN_SIMPLE 0
#endif
#ifndef MK_SKEL
#define MK_SKEL 0
#endif

constexpr int D = 2048, BATCH = 4, SEQ = 2048, DEPTH = 4, M = BATCH * SEQ;
constexpr int HD = 128, DATT = 1024, NHEAD = 8, DSC = 512, DCF = 512, DFF = 8192, NIN = 11776;
constexpr int SCW = 3, CFW = 31;
constexpr float RMS_EPS = 1e-6f, LN_EPS = 1e-5f;
constexpr int C_Q = 0, C_K = 1024, C_V = 2048, C_SB = 3072, C_SC = 3584, C_SU = 4096, C_CA = 4608, C_CG = 5120, C_G = 5632;
constexpr int Z_A = 0, Z_B = 512, Z_C = 1536;
constexpr float QSCALE = 0.08838834764831845f * 1.4426950408889634f;

namespace pg8 {
#define PG8_LAS __attribute__((address_space(3)))
typedef unsigned short bf16_t;
typedef short bf16x8 __attribute__((ext_vector_type(8)));
typedef float f32x4 __attribute__((ext_vector_type(4)));
typedef unsigned u32x4 __attribute__((ext_vector_type(4)));
constexpr int BM = 256, BK = 64, HALF = 128, HTB = HALF * BK * 2, STAGE_BYTES = 8 * HTB, NXCD = 8, WGM = 8;

__host__ __device__ __forceinline__ int lds_byte(int r, int c) { const int st = (r >> 4) * 2 + (c >> 5), rr = r & 15, cc = c & 31, ob = rr * 64 + cc * 2; return st * 1024 + (ob ^ (((ob >> 9) & 1) << 5)); }
__host__ __device__ __forceinline__ void stage_rc(int b, int& R, int& C) { const int st = b / 1024, sb = b % 1024, swz = sb ^ (((sb >> 9) & 1) << 5); R = (st >> 1) * 16 + swz / 64; C = (st & 1) * 32 + (swz % 64) / 2; }
__host__ __device__ __forceinline__ int perm32(int rho) { const int n = rho >> 4, i = rho & 15; return 8 * (i >> 2) + 4 * n + (i & 3); }

struct Unit { int pm, pn; };
struct Gemm { const bf16_t* A; const bf16_t* Bt; int M, N, K; };

struct StaticOrder {
    int nM, nN, nwg, G, c;
    __host__ __device__ void init(int M_, int N_, int G_, int c_) { nM = M_ / BM; nN = N_ / BM; nwg = nM * nN; G = G_; c = c_; }
    __host__ __device__ bool next(int i, Unit& u) const {
        const long L = (long)i * G + c; if (L >= nwg) return false;
        int wgid = (int)L; { const int q = nwg / NXCD, r = nwg % NXCD, xcd = wgid % NXCD, off = wgid / NXCD; wgid = (xcd < r ? xcd * (q + 1) : r * (q + 1) + (xcd - r) * q) + off; }
        const int nig = WGM * nN, gid = wgid / nig, fm = gid * WGM, gsz = (nM - fm) < WGM ? (nM - fm) : WGM;
        u.pm = fm + ((wgid % nig) % gsz); u.pn = (wgid % nig) / gsz; return true;
    }
    __device__ __forceinline__ void a_ready(const Unit&) const {}
    __device__ __forceinline__ void done(const Unit&) const {}
};

__device__ __forceinline__ unsigned cvt_pk_bf16(float lo, float hi) { unsigned r; asm volatile("v_cvt_pk_bf16_f32 %0, %1, %2" : "=v"(r) : "v"(lo), "v"(hi)); return r; }
__device__ __forceinline__ float bf_lo(unsigned w) { return __uint_as_float(w << 16); }
__device__ __forceinline__ float bf_hi(unsigned w) { return __uint_as_float(w & 0xffff0000u); }
__device__ __forceinline__ float sigmoidf_fast(float x) { return __builtin_amdgcn_rcpf(1.0f + __builtin_amdgcn_exp2f(-1.4426950408889634f * x)); }


struct EpiIn {
    static constexpr bool PERM = true, AFTER_DRAIN = false, SEG = false; static constexpr int T1 = -1, T2 = -1;
    bf16_t* O;
    __device__ __forceinline__ void rescale(f32x4 (&)[2][2][4][2], const Unit&, int, int, int, int, int) const {}
    __device__ __forceinline__ void operator()(const f32x4 (&acc)[2][2][4][2], const Unit& u, int wr, int wc, int fr, int fq) const {
        const int row0 = u.pm * BM + wr * 64 + fr, col0 = u.pn * BM + wc * 32 + 8 * fq;
        const int mode = (u.pn < 4) ? 1 : ((u.pn >= 22) ? 2 : 0);
#pragma unroll
        for (int ai = 0; ai < 2; ++ai)
#pragma unroll
            for (int m = 0; m < 4; ++m) { bf16_t* rowp = O + (size_t)(row0 + ai * HALF + m * 16) * NIN + col0;
#pragma unroll
                for (int bj = 0; bj < 2; ++bj) { f32x4 v0 = acc[ai][bj][m][0], v1 = acc[ai][bj][m][1];
                    if (mode == 1) { v0 = v0 * QSCALE; v1 = v1 * QSCALE; }
                    if (mode == 2) {
#pragma unroll
                        for (int j = 0; j < 4; ++j) { v0[j] = fmaxf(sigmoidf_fast(v0[j]), 1e-30f); v1[j] = fmaxf(sigmoidf_fast(v1[j]), 1e-30f); } }
                    u32x4 w; w.x = cvt_pk_bf16(v0[0], v0[1]); w.y = cvt_pk_bf16(v0[2], v0[3]); w.z = cvt_pk_bf16(v1[0], v1[1]); w.w = cvt_pk_bf16(v1[2], v1[3]);
                    *(u32x4*)(rowp + bj * HALF) = w; } }
    }
};
struct EpiMix {
    static constexpr bool PERM = true, AFTER_DRAIN = false, SEG = true; static constexpr int T1 = 8, T2 = 24;
    bf16_t* O; const bf16_t* G;
    __device__ __forceinline__ void rescale(f32x4 (&acc)[2][2][4][2], const Unit& u, int t, int wr, int wc, int fr, int fq) const {
        const unsigned loff = (unsigned)(fr * NIN + 8 * fq) * 2u;
        const char* ub = (const char*)G + ((size_t)(u.pm * BM + wr * 64) * NIN + u.pn * BM + wc * 32 + (t == T1 ? 0 : D)) * 2;
#pragma unroll
        for (int ai = 0; ai < 2; ++ai)
#pragma unroll
            for (int m = 0; m < 4; ++m) { const char* gp = ub + (size_t)(ai * HALF + m * 16) * NIN * 2;
#pragma unroll
                for (int bj = 0; bj < 2; ++bj) { const u32x4 nu = *(const u32x4*)(gp + bj * HALF * 2 + loff), de = *(const u32x4*)(gp + (D + bj * HALF) * 2 + loff);
                    f32x4 r0, r1;
                    r0[0] = bf_lo(nu.x) * __builtin_amdgcn_rcpf(bf_lo(de.x)); r0[1] = bf_hi(nu.x) * __builtin_amdgcn_rcpf(bf_hi(de.x));
                    r0[2] = bf_lo(nu.y) * __builtin_amdgcn_rcpf(bf_lo(de.y)); r0[3] = bf_hi(nu.y) * __builtin_amdgcn_rcpf(bf_hi(de.y));
                    r1[0] = bf_lo(nu.z) * __builtin_amdgcn_rcpf(bf_lo(de.z)); r1[1] = bf_hi(nu.z) * __builtin_amdgcn_rcpf(bf_hi(de.z));
                    r1[2] = bf_lo(nu.w) * __builtin_amdgcn_rcpf(bf_lo(de.w)); r1[3] = bf_hi(nu.w) * __builtin_amdgcn_rcpf(bf_hi(de.w));
                    acc[ai][bj][m][0] = acc[ai][bj][m][0] * r0; acc[ai][bj][m][1] = acc[ai][bj][m][1] * r1; }
                if (m & 1) asm volatile("" ::: "memory"); }
    }
    __device__ __forceinline__ void operator()(const f32x4 (&acc)[2][2][4][2], const Unit& u, int wr, int wc, int fr, int fq) const {
        const int row0 = u.pm * BM + wr * 64 + fr, col0 = u.pn * BM + wc * 32 + 8 * fq;
#pragma unroll
        for (int ai = 0; ai < 2; ++ai)
#pragma unroll
            for (int m = 0; m < 4; ++m) { const size_t r = (size_t)(row0 + ai * HALF + m * 16); const bf16_t* gp = G + r * NIN + 2 * D + col0; bf16_t* rowp = O + r * D + col0;
#pragma unroll
                for (int bj = 0; bj < 2; ++bj) { const u32x4 g = *(const u32x4*)(gp + bj * HALF); f32x4 v0 = acc[ai][bj][m][0], v1 = acc[ai][bj][m][1];
                    v0[0] *= bf_lo(g.x); v0[1] *= bf_hi(g.x); v0[2] *= bf_lo(g.y); v0[3] *= bf_hi(g.y); v1[0] *= bf_lo(g.z); v1[1] *= bf_hi(g.z); v1[2] *= bf_lo(g.w); v1[3] *= bf_hi(g.w);
                    u32x4 w; w.x = cvt_pk_bf16(v0[0], v0[1]); w.y = cvt_pk_bf16(v0[2], v0[3]); w.z = cvt_pk_bf16(v1[0], v1[1]); w.w = cvt_pk_bf16(v1[2], v1[3]);
                    *(u32x4*)(rowp + bj * HALF) = w; }
                if (m & 1) asm volatile("" ::: "memory"); }
    }
};
struct EpiF32 {
    static constexpr bool PERM = false, AFTER_DRAIN = false, SEG = false; static constexpr int T1 = -1, T2 = -1;
    float* C; int ldc;
    __device__ __forceinline__ void rescale(f32x4 (&)[2][2][4][2], const Unit&, int, int, int, int, int) const {}
    __device__ __forceinline__ void operator()(const f32x4 (&acc)[2][2][4][2], const Unit& u, int wr, int wc, int fr, int fq) const {
        const int row0 = u.pm * BM + wr * 64 + fr, col0 = u.pn * BM + wc * 32 + 4 * fq;
#pragma unroll
        for (int ai = 0; ai < 2; ++ai)
#pragma unroll
            for (int m = 0; m < 4; ++m) { float* rowp = C + (size_t)(row0 + ai * HALF + m * 16) * ldc + col0;
#pragma unroll
                for (int bj = 0; bj < 2; ++bj)
#pragma unroll
                    for (int n = 0; n < 2; ++n) *(f32x4*)(rowp + bj * HALF + n * 16) = acc[ai][bj][m][n]; }
    }
};
struct EpiRelu2 {
    static constexpr bool PERM = true, AFTER_DRAIN = false, SEG = false; static constexpr int T1 = -1, T2 = -1;
    bf16_t* O; int ldc;
    __device__ __forceinline__ void rescale(f32x4 (&)[2][2][4][2], const Unit&, int, int, int, int, int) const {}
    __device__ __forceinline__ void operator()(const f32x4 (&acc)[2][2][4][2], const Unit& u, int wr, int wc, int fr, int fq) const {
        const int row0 = u.pm * BM + wr * 64 + fr, col0 = u.pn * BM + wc * 32 + 8 * fq;
#pragma unroll
        for (int ai = 0; ai < 2; ++ai)
#pragma unroll
            for (int m = 0; m < 4; ++m) { bf16_t* rowp = O + (size_t)(row0 + ai * HALF + m * 16) * ldc + col0;
#pragma unroll
                for (int bj = 0; bj < 2; ++bj) { f32x4 v0 = acc[ai][bj][m][0], v1 = acc[ai][bj][m][1];
#pragma unroll
                    for (int j = 0; j < 4; ++j) { const float a = fmaxf(v0[j], 0.f), b = fmaxf(v1[j], 0.f); v0[j] = a * a; v1[j] = b * b; }
                    u32x4 w; w.x = cvt_pk_bf16(v0[0], v0[1]); w.y = cvt_pk_bf16(v0[2], v0[3]); w.z = cvt_pk_bf16(v1[0], v1[1]); w.w = cvt_pk_bf16(v1[2], v1[3]);
                    *(u32x4*)(rowp + bj * HALF) = w; } }
    }
};

template <class Epi, class Sched, bool ALIGN_EPI = false, bool SP2 = false>
__device__ __forceinline__ void gemm_phase(PG8_LAS unsigned char* lds, const Gemm g, const Sched& S, const Epi& E) {
    int tid_ = threadIdx.x; asm volatile("" : "+v"(tid_));
    const int tid = tid_, wid = __builtin_amdgcn_readfirstlane(tid >> 6), lane = tid & 63, wr = wid >> 2, wc = wid & 3, fr = lane & 15, fq = lane >> 4;
    const int K = g.K, nt = K / BK;
    unsigned voffA[2], voffB[2];
#pragma unroll
    for (int i = 0; i < 2; ++i) { int R, C; stage_rc(tid * 16 + i * 8192, R, C); const int Rb = Epi::PERM ? ((R & ~31) + perm32(R & 31)) : R;
        voffA[i] = (unsigned)(R * K + C) * 2u; voffB[i] = (unsigned)(Rb * K + C) * 2u; }
    const size_t kstep = (size_t)(BK * 2);
    const size_t hstep = (size_t)HALF * K * 2;
    const size_t tstep = 2 * hstep;
    const unsigned ldsw = (unsigned)wid * 1024u;
    const int aoff = lds_byte(wr * 64 + fr, fq * 8), boff = lds_byte(wc * 32 + fr, fq * 8);
#define PG8_SA(b, h) (((b) * 2 + (h)) * HTB)
#define PG8_SB(b, h) ((4 + (b) * 2 + (h)) * HTB)
#define PG8_STAGE(bufoff, gbase, voff) do { _Pragma("unroll") for (int _i = 0; _i < 2; ++_i) \
        __builtin_amdgcn_global_load_lds((const unsigned*)((const char*)(gbase) + (voff)[_i]), (PG8_LAS unsigned*)(lds + (bufoff) + ldsw + _i * 8192), 16, 0, 0); } while (0)
#define PG8_LDA(dst, b, h) do { _Pragma("unroll") for (int m = 0; m < 4; ++m) _Pragma("unroll") for (int k = 0; k < 2; ++k) dst[m][k] = *(const PG8_LAS bf16x8*)(lds + PG8_SA(b, h) + aoff + m * 2048 + k * 1024); } while (0)
#define PG8_LDB(dst, b, h) do { _Pragma("unroll") for (int n = 0; n < 2; ++n) _Pragma("unroll") for (int k = 0; k < 2; ++k) dst[n][k] = *(const PG8_LAS bf16x8*)(lds + PG8_SB(b, h) + boff + n * 2048 + k * 1024); } while (0)
#define PG8_MMA(ai, bj, At, Bt) do { __builtin_amdgcn_s_setprio(1); _Pragma("unroll") for (int m = 0; m < 4; ++m) _Pragma("unroll") for (int n = 0; n < 2; ++n) _Pragma("unroll") for (int k = 0; k < 2; ++k) \
        acc[ai][bj][m][n] = __builtin_amdgcn_mfma_f32_16x16x32_bf16(Bt[n][k], At[m][k], acc[ai][bj][m][n], 0, 0, 0); __builtin_amdgcn_s_setprio(0); } while (0)
#define PG8_WAIT_V(n) asm volatile("s_waitcnt vmcnt(" #n ")" ::: "memory")
#define PG8_WAIT_L(n) asm volatile("s_waitcnt lgkmcnt(" #n ")" ::: "memory")
#define PG8_BAR __builtin_amdgcn_s_barrier()
#define PG8_SCHED __builtin_amdgcn_sched_barrier(0)
    Unit cur, nxt; int ui = 0;
    if (!S.next(0, cur)) return;
    f32x4 acc[2][2][4][2];
#pragma unroll
    for (int a = 0; a < 2; ++a)
#pragma unroll
        for (int b = 0; b < 2; ++b)
#pragma unroll
            for (int m = 0; m < 4; ++m)
#pragma unroll
                for (int n = 0; n < 2; ++n) acc[a][b][m][n] = (f32x4){0.f, 0.f, 0.f, 0.f};
    bf16x8 At[4][2], B0[2][2], B1[2][2];
    const char* cA = (const char*)g.A + (size_t)cur.pm * tstep; const char* cB = (const char*)g.Bt + (size_t)cur.pn * tstep;
    S.a_ready(cur);
    if constexpr (SP2) {
        PG8_STAGE(PG8_SB(0, 0), cB, voffB); PG8_STAGE(PG8_SB(0, 1), cB + hstep, voffB); PG8_STAGE(PG8_SA(0, 0), cA, voffA); PG8_STAGE(PG8_SA(0, 1), cA + hstep, voffA);
        if (wr == 1) PG8_BAR;
        PG8_WAIT_V(2); PG8_BAR;
        PG8_STAGE(PG8_SB(1, 0), cB + kstep, voffB); PG8_STAGE(PG8_SA(1, 0), cA + kstep, voffA); PG8_STAGE(PG8_SB(1, 1), cB + hstep + kstep, voffB);
        PG8_WAIT_V(6); PG8_BAR;
    } else {
        PG8_STAGE(PG8_SB(0, 0), cB, voffB); PG8_STAGE(PG8_SA(0, 0), cA, voffA); PG8_STAGE(PG8_SB(0, 1), cB + hstep, voffB); PG8_STAGE(PG8_SA(0, 1), cA + hstep, voffA);
        if (wr == 1) PG8_BAR;
        PG8_WAIT_V(4); PG8_BAR;
        PG8_STAGE(PG8_SB(1, 0), cB + kstep, voffB); PG8_STAGE(PG8_SA(1, 0), cA + kstep, voffA); PG8_STAGE(PG8_SB(1, 1), cB + hstep + kstep, voffB);
        PG8_WAIT_V(6); PG8_BAR;
    }
    for (;;) {
        const bool has_next = S.next(ui + 1, nxt);
        const char* nA = has_next ? (const char*)g.A + (size_t)nxt.pm * tstep : cA; const char* nB = has_next ? (const char*)g.Bt + (size_t)nxt.pn * tstep : cB;
        for (int t = 0; t < nt; t += 2) {
            const bool last = (t == nt - 2);
            if constexpr (Epi::SEG) { if (t == Epi::T1 || t == Epi::T2) E.rescale(acc, cur, t, wr, wc, fr, fq); }
            const char* a1 = cA + (size_t)(t + 1) * kstep;
            const char* a2 = last ? nA : cA + (size_t)(t + 2) * kstep; const char* b2 = last ? nB : cB + (size_t)(t + 2) * kstep;
            const char* a3 = a2 + kstep; const char* b3 = b2 + kstep;
            if (last && has_next) S.a_ready(nxt);
            if constexpr (SP2) {
            PG8_LDB(B0, 0, 0); PG8_LDB(B1, 0, 1); PG8_SCHED; PG8_LDA(At, 0, 0); PG8_STAGE(PG8_SA(1, 1), a1 + hstep, voffA);
            PG8_WAIT_V(8); PG8_WAIT_L(0); PG8_BAR; PG8_MMA(0, 0, At, B0); PG8_MMA(0, 1, At, B1); PG8_BAR; PG8_SCHED;
            PG8_LDA(At, 0, 1); PG8_STAGE(PG8_SB(0, 0), b2, voffB); PG8_STAGE(PG8_SB(0, 1), b2 + hstep, voffB); PG8_STAGE(PG8_SA(0, 0), a2, voffA);
            PG8_WAIT_V(8); PG8_WAIT_L(0); PG8_BAR; PG8_MMA(1, 0, At, B0); PG8_MMA(1, 1, At, B1); PG8_BAR; PG8_SCHED;
            PG8_LDB(B0, 1, 0); PG8_LDB(B1, 1, 1); PG8_SCHED; PG8_LDA(At, 1, 0); PG8_STAGE(PG8_SA(0, 1), a2 + hstep, voffA);
            PG8_WAIT_V(8); PG8_WAIT_L(0); PG8_BAR; PG8_MMA(0, 0, At, B0); PG8_MMA(0, 1, At, B1); PG8_BAR; PG8_SCHED;
            PG8_LDA(At, 1, 1); PG8_STAGE(PG8_SB(1, 0), b3, voffB); PG8_STAGE(PG8_SB(1, 1), b3 + hstep, voffB); PG8_STAGE(PG8_SA(1, 0), a3, voffA);
            PG8_WAIT_V(8); PG8_WAIT_L(0); PG8_BAR; PG8_MMA(1, 0, At, B0); PG8_MMA(1, 1, At, B1); PG8_BAR; PG8_SCHED;
            } else {
            PG8_LDB(B0, 0, 0); PG8_SCHED; PG8_LDA(At, 0, 0); PG8_STAGE(PG8_SA(1, 1), a1 + hstep, voffA);
            PG8_WAIT_L(8); PG8_BAR; PG8_WAIT_L(0); PG8_MMA(0, 0, At, B0); PG8_BAR; PG8_SCHED;
            PG8_LDB(B1, 0, 1); PG8_STAGE(PG8_SB(0, 0), b2, voffB);
            PG8_BAR; PG8_WAIT_L(0); PG8_MMA(0, 1, At, B1); PG8_BAR;
            PG8_LDA(At, 0, 1); PG8_STAGE(PG8_SA(0, 0), a2, voffA);
            PG8_BAR; PG8_WAIT_L(0); PG8_MMA(1, 0, At, B0); PG8_BAR; PG8_SCHED;
            PG8_STAGE(PG8_SB(0, 1), b2 + hstep, voffB);
            PG8_WAIT_V(6); PG8_BAR; PG8_MMA(1, 1, At, B1); PG8_BAR;
            PG8_LDB(B0, 1, 0); PG8_SCHED; PG8_LDA(At, 1, 0); PG8_STAGE(PG8_SA(0, 1), a2 + hstep, voffA);
            PG8_WAIT_L(8); PG8_BAR; PG8_WAIT_L(0); PG8_MMA(0, 0, At, B0); PG8_BAR; PG8_SCHED;
            PG8_LDB(B1, 1, 1); PG8_STAGE(PG8_SB(1, 0), b3, voffB);
            PG8_BAR; PG8_WAIT_L(0); PG8_MMA(0, 1, At, B1); PG8_BAR;
            PG8_LDA(At, 1, 1); PG8_STAGE(PG8_SA(1, 0), a3, voffA);
            PG8_BAR; PG8_WAIT_L(0); PG8_MMA(1, 0, At, B0); PG8_BAR; PG8_SCHED;
            PG8_STAGE(PG8_SB(1, 1), b3 + hstep, voffB);
            PG8_WAIT_V(6); PG8_BAR; PG8_MMA(1, 1, At, B1); PG8_BAR;
            }
        }
        if constexpr (ALIGN_EPI) { if (wr == 0) PG8_BAR; }
        E(acc, cur, wr, wc, fr, fq); S.done(cur);
        if (!has_next) break;
#pragma unroll
        for (int a = 0; a < 2; ++a)
#pragma unroll
            for (int b = 0; b < 2; ++b)
#pragma unroll
                for (int m = 0; m < 4; ++m)
#pragma unroll
                    for (int n = 0; n < 2; ++n) acc[a][b][m][n] = (f32x4){0.f, 0.f, 0.f, 0.f};
        cur = nxt; cA = nA; cB = nB; ++ui;
        if constexpr (ALIGN_EPI) { if (wr == 1) PG8_BAR; }
    }
    PG8_WAIT_V(0);
    if constexpr (!ALIGN_EPI) { if (wr == 0) PG8_BAR; }
    PG8_BAR;
#undef PG8_SA
#undef PG8_SB
#undef PG8_STAGE
#undef PG8_LDA
#undef PG8_LDB
#undef PG8_MMA
#undef PG8_WAIT_V
#undef PG8_WAIT_L
#undef PG8_BAR
#undef PG8_SCHED
}
}

constexpr int NWAVES = 8;
constexpr size_t MiB = 1u << 20;
constexpr size_t WS_CTL = 0, CTL_ZERO_BYTES = 1 * MiB;
constexpr size_t WL_IN = 0, WL_PABC = 46 * MiB, WL_O = 54 * MiB, WL_UP = 62 * MiB, WL_DOWN = 94 * MiB, WL_STRIDE = 126 * MiB;
constexpr size_t WS_W = 1 * MiB;
constexpr size_t WS_H = WS_W + DEPTH * WL_STRIDE;
constexpr size_t WS_PROJ = WS_H + 32 * MiB;
constexpr size_t WS_Z = WS_PROJ + 184 * MiB;
constexpr size_t WS_MIX = WS_Z + 32 * MiB;
constexpr size_t WS_Y = WS_MIX + 32 * MiB;
constexpr size_t WS_F = WS_Y + 64 * MiB;
constexpr size_t WS_END = WS_F + 128 * MiB;
static_assert((size_t)NIN * D * 2 == 46 * MiB && (size_t)M * NIN * 2 == 184 * MiB, "map");
constexpr int CW_TMO = 0, CW_CODE = 1, CW_BAR = 4096;

constexpr int RING_OFF = 0, PHASE_LDS = 143360;
constexpr int LDSCTL_OFF = PHASE_LDS, MISC_OFF = LDSCTL_OFF + 320, LDS_BYTES = 147456;

#define GAS __attribute__((address_space(1)))
#define LAS __attribute__((address_space(3)))
typedef unsigned short bf16;
typedef unsigned v4u __attribute__((ext_vector_type(4)));
typedef unsigned v2u __attribute__((ext_vector_type(2)));
typedef float f32x4 __attribute__((ext_vector_type(4)));
typedef GAS unsigned gu32;
#define RLX_AGENT __ATOMIC_RELAXED, __HIP_MEMORY_SCOPE_AGENT
#define LDS_WAIT() asm volatile("s_waitcnt lgkmcnt(0)" ::: "memory")
#define VM_WAIT() asm volatile("s_waitcnt vmcnt(0)" ::: "memory")
using pg8::cvt_pk_bf16; using pg8::bf_lo; using pg8::bf_hi;

#define XB_TMO      128
#define XB_XCNT(j)  (256  + 64 * (j))
#define XB_XSUB(j)  (1280 + 64 * (j))
#define XB_XGEN(j)  (2304 + 64 * (j))
#define XB_TOP      3328
#define XB_TOPGEN   3392
#define XCD_BAR_WORDS 3456
#define XB_SPIN_CAP (1u << 18)
__device__ __forceinline__ unsigned xb_ld(unsigned* p)              { return __hip_atomic_load(p, __ATOMIC_RELAXED, __HIP_MEMORY_SCOPE_AGENT); }
__device__ __forceinline__ unsigned xb_add(unsigned* p, unsigned v) { return __hip_atomic_fetch_add(p, v, __ATOMIC_RELAXED, __HIP_MEMORY_SCOPE_AGENT); }
__device__ __forceinline__ unsigned xb_xcc_id() { return (unsigned)__builtin_amdgcn_s_getreg((3 << 11) | 20) & 0xFu; }
#define XB_SPIN(cond, bar) do { unsigned _sp = 0; while (cond) { __builtin_amdgcn_s_sleep(1); \
    if ((++_sp & 255u) == 0u) { if (xb_ld(&(bar)[XB_TMO])) break; if (_sp > XB_SPIN_CAP) { atomicAdd(&(bar)[XB_TMO], 1u); break; } } } } while (0)
struct XcdBarrier { unsigned* bar; unsigned x; volatile LAS unsigned* st; };
__device__ __forceinline__ XcdBarrier xcd_barrier_post(unsigned* bar, volatile LAS unsigned* st) {
    XcdBarrier b; b.bar = bar; b.x = xb_xcc_id(); b.st = st;
    if (threadIdx.x == 0) (void)xb_add(&bar[XB_XCNT(b.x)], 1u);
    return b;
}
__device__ __forceinline__ void xcd_barrier_complete(unsigned* bar, unsigned x, unsigned& nloc, unsigned& nx) {
    const unsigned G = gridDim.x * gridDim.y * gridDim.z;
    unsigned sum, cnt, mine, sp = 0u;
    for (;;) {
        sum = 0u; cnt = 0u; mine = 0u;
#pragma unroll
        for (unsigned j = 0; j < 16; ++j) { const unsigned c = xb_ld(&bar[XB_XCNT(j)]); sum += c; cnt += (c > 0u) ? 1u : 0u; mine = (j == x) ? c : mine; }
        if (sum == G) break;
        __builtin_amdgcn_s_sleep(1);
        if ((++sp & 255u) == 0u) { if (xb_ld(&bar[XB_TMO])) break; if (sp > XB_SPIN_CAP) { atomicAdd(&bar[XB_TMO], 1u); break; } }
    }
    nloc = mine > 0u ? mine : 1u; nx = cnt > 0u ? cnt : 1u;
}
__device__ __forceinline__ void xcd_barrier(const XcdBarrier& b) {
    asm volatile("s_waitcnt vmcnt(0)" ::: "memory");
    __syncthreads();
    if (threadIdx.x == 0) {
        unsigned* bar = b.bar;
        __builtin_amdgcn_s_waitcnt(0);
        unsigned nloc = b.st[0], nx = b.st[1];
        if (nloc == 0u) { xcd_barrier_complete(bar, b.x, nloc, nx); b.st[0] = nloc; b.st[1] = nx; }
        const unsigned old = xb_add(&bar[XB_XSUB(b.x)], 1u);
        const unsigned gen = old / nloc;
        if (old + 1u == (gen + 1u) * nloc) {
            __builtin_amdgcn_fence(__ATOMIC_RELEASE, "agent");
            asm volatile("s_waitcnt vmcnt(0)" ::: "memory");
            const unsigned og = xb_add(&bar[XB_TOP], 1u);
            const unsigned tg = og / nx;
            if (og + 1u == (tg + 1u) * nx) xb_add(&bar[XB_TOPGEN], 1u);
            else XB_SPIN(xb_ld(&bar[XB_TOPGEN]) == tg, bar);
            __builtin_amdgcn_fence(__ATOMIC_ACQUIRE, "agent");
            xb_add(&bar[XB_XGEN(b.x)], 1u);
            asm volatile("s_waitcnt vmcnt(0)" ::: "memory");
        } else {
            XB_SPIN(xb_ld(&bar[XB_XGEN(b.x)]) == gen, bar);
            __builtin_amdgcn_fence(__ATOMIC_ACQUIRE, "agent");
            asm volatile("s_waitcnt vmcnt(0)" ::: "memory");
        }
    }
    __syncthreads();
}

struct Frame {
    LAS unsigned char* lds;
    int vcu, G;
    const float *x, *ln_mix_pre, *ln_mix_post, *ln_mlp_pre, *ln_mlp_post, *w_in, *conv_a_w, *proj_a, *proj_b, *conv_c_w, *conv_c_b, *norm_c_g, *norm_c_b, *proj_c, *w_o, *w_up, *w_down;
    float* out;
    unsigned char* ws;
    bf16 *H, *PROJ, *Z, *MIX, *F; float* Y;
};
__device__ __forceinline__ bf16* wl(const Frame& F, int l, size_t off) { return (bf16*)(F.ws + WS_W + (size_t)l * WL_STRIDE + off); }

__device__ __forceinline__ int fresh_tid() { int t = threadIdx.x; asm volatile("" : "+v"(t)); return t; }
__device__ __forceinline__ float wave_sum(float v) {
#pragma unroll
    for (int o = 1; o < 64; o <<= 1) v += __shfl_xor(v, o);
    return v;
}

__device__ __forceinline__ void transpose_item(const float* __restrict__ W, int N, bf16* __restrict__ WT, int ldk, int koff, int kb, int nb, LAS float* scr, int lane) {
    const int k0 = kb * 64, n0 = nb * 64, kr = lane >> 4, n4 = lane & 15;
    f32x4 v[16];
#pragma unroll
    for (int i = 0; i < 16; ++i) v[i] = *(const GAS f32x4*)(W + (size_t)(k0 + 4 * i + kr) * N + n0 + 4 * n4);
#pragma unroll
    for (int i = 0; i < 16; ++i) { LAS float* s = scr + (4 * i + kr) * 65 + 4 * n4; s[0] = v[i].x; s[1] = v[i].y; s[2] = v[i].z; s[3] = v[i].w; }
    LDS_WAIT(); asm volatile("" ::: "memory");
    const int kc = lane >> 3, nr = lane & 7;
#pragma unroll
    for (int j = 0; j < 8; ++j) { const int n = 8 * j + nr; const LAS float* s = scr + (8 * kc) * 65 + n;
        v4u o; o.x = cvt_pk_bf16(s[0 * 65], s[1 * 65]); o.y = cvt_pk_bf16(s[2 * 65], s[3 * 65]); o.z = cvt_pk_bf16(s[4 * 65], s[5 * 65]); o.w = cvt_pk_bf16(s[6 * 65], s[7 * 65]);
        *(GAS v4u*)(WT + (size_t)(n0 + n) * ldk + koff + k0 + 8 * kc) = o; }
    LDS_WAIT(); asm volatile("" ::: "memory");
}
__device__ __forceinline__ void rms_row_to_bf16(const float* xrow, const float* gain, bf16* orow, int lane) {
    const GAS f32x4* xr = (const GAS f32x4*)xrow + lane; const GAS f32x4* gr = (const GAS f32x4*)gain + lane;
    f32x4 v[8]; float s = 0.f;
#pragma unroll
    for (int j = 0; j < 8; ++j) { v[j] = xr[64 * j]; s += (v[j].x * v[j].x + v[j].y * v[j].y) + (v[j].z * v[j].z + v[j].w * v[j].w); }
    const float r = 1.0f / sqrtf(wave_sum(s) * (1.f / D) + RMS_EPS);
    GAS v2u* o8 = (GAS v2u*)orow + lane;
#pragma unroll
    for (int j = 0; j < 8; ++j) { const f32x4 g = gr[64 * j]; v2u o; o.x = cvt_pk_bf16(v[j].x * r * g.x, v[j].y * r * g.y); o.y = cvt_pk_bf16(v[j].z * r * g.z, v[j].w * r * g.w); o8[64 * j] = o; }
}
__device__ __forceinline__ void p0_prologue(Frame& F) {
    const int tid = fresh_tid(), lane = tid & 63, wave = __builtin_amdgcn_readfirstlane(tid >> 6);
    LAS float* scr = (LAS float*)(F.lds + RING_OFF) + wave * (64 * 65);
    const int gw = F.vcu * NWAVES + wave, NGW = F.G * NWAVES;
    constexpr int I_IN = (D / 64) * (NIN / 64), I_A = (DSC / 64) * (D / 64), I_B = (DATT / 64) * (D / 64), I_C = (DCF / 64) * (D / 64), I_O = (D / 64) * (D / 64), I_UP = (D / 64) * (DFF / 64), I_DN = (DFF / 64) * (D / 64);
    constexpr int PER_L = I_IN + I_A + I_B + I_C + I_O + I_UP + I_DN;
    for (int it = gw; it < DEPTH * PER_L; it += NGW) {
        const int l = it / PER_L; int r = it - l * PER_L;
        if (r < I_IN) { transpose_item(F.w_in + (size_t)l * D * NIN, NIN, wl(F, l, WL_IN), D, 0, r / (NIN / 64), r % (NIN / 64), scr, lane); continue; } r -= I_IN;
        if (r < I_A)  { transpose_item(F.proj_a + (size_t)l * DSC * D, D, wl(F, l, WL_PABC), D, Z_A, r / (D / 64), r % (D / 64), scr, lane); continue; } r -= I_A;
        if (r < I_B)  { transpose_item(F.proj_b + (size_t)l * DATT * D, D, wl(F, l, WL_PABC), D, Z_B, r / (D / 64), r % (D / 64), scr, lane); continue; } r -= I_B;
        if (r < I_C)  { transpose_item(F.proj_c + (size_t)l * DCF * D, D, wl(F, l, WL_PABC), D, Z_C, r / (D / 64), r % (D / 64), scr, lane); continue; } r -= I_C;
        if (r < I_O)  { transpose_item(F.w_o + (size_t)l * D * D, D, wl(F, l, WL_O), D, 0, r / (D / 64), r % (D / 64), scr, lane); continue; } r -= I_O;
        if (r < I_UP) { transpose_item(F.w_up + (size_t)l * D * DFF, DFF, wl(F, l, WL_UP), D, 0, r / (DFF / 64), r % (DFF / 64), scr, lane); continue; } r -= I_UP;
        transpose_item(F.w_down + (size_t)l * DFF * D, D, wl(F, l, WL_DOWN), DFF, 0, r / (D / 64), r % (D / 64), scr, lane);
    }
    for (int m = gw; m < M; m += NGW) rms_row_to_bf16(F.x + (size_t)m * D, F.ln_mix_pre, F.H + (size_t)m * D, lane);
}

__device__ __forceinline__ void norm_phase(Frame& F, const float* xprev, const float* g_post, const float* g_next) {
    const int tid = fresh_tid(), lane = tid & 63, wave = __builtin_amdgcn_readfirstlane(tid >> 6);
    const int gw = F.vcu * NWAVES + wave, NGW = F.G * NWAVES;
    for (int m = gw; m < M; m += NGW) {
        const GAS f32x4* yr = (const GAS f32x4*)(F.Y + (size_t)m * D) + lane; const GAS f32x4* xr = (const GAS f32x4*)(xprev + (size_t)m * D) + lane;
        const GAS f32x4* gp = (const GAS f32x4*)g_post + lane; GAS f32x4* xo = (GAS f32x4*)(F.out + (size_t)m * D) + lane;
        f32x4 y[8], x[8]; float s = 0.f;
#pragma unroll
        for (int j = 0; j < 8; ++j) { y[j] = yr[64 * j]; x[j] = xr[64 * j]; }
#pragma unroll
        for (int j = 0; j < 8; ++j) s += (y[j].x * y[j].x + y[j].y * y[j].y) + (y[j].z * y[j].z + y[j].w * y[j].w);
        const float r1 = 1.0f / sqrtf(wave_sum(s) * (1.f / D) + RMS_EPS);
        float s2 = 0.f;
#pragma unroll
        for (int j = 0; j < 8; ++j) { const f32x4 g = gp[64 * j]; x[j] = x[j] + (y[j] * r1) * g; xo[64 * j] = x[j]; s2 += (x[j].x * x[j].x + x[j].y * x[j].y) + (x[j].z * x[j].z + x[j].w * x[j].w); }
        if (g_next) {
            const float r2 = 1.0f / sqrtf(wave_sum(s2) * (1.f / D) + RMS_EPS);
            const GAS f32x4* gn = (const GAS f32x4*)g_next + lane; GAS v2u* o8 = (GAS v2u*)(F.H + (size_t)m * D) + lane;
#pragma unroll
            for (int j = 0; j < 8; ++j) { const f32x4 g = gn[64 * j]; v2u o; o.x = cvt_pk_bf16(x[j].x * r2 * g.x, x[j].y * r2 * g.y); o.y = cvt_pk_bf16(x[j].z * r2 * g.z, x[j].w * r2 * g.w); o8[64 * j] = o; }
        }
    }
}

__device__ __forceinline__ void unpack8(const v4u w, float (&f)[8]) { f[0] = bf_lo(w.x); f[1] = bf_hi(w.x); f[2] = bf_lo(w.y); f[3] = bf_hi(w.y); f[4] = bf_lo(w.z); f[5] = bf_hi(w.z); f[6] = bf_lo(w.w); f[7] = bf_hi(w.w); }
__device__ __forceinline__ v4u pack8(const float (&f)[8]) { v4u o; o.x = cvt_pk_bf16(f[0], f[1]); o.y = cvt_pk_bf16(f[2], f[3]); o.z = cvt_pk_bf16(f[4], f[5]); o.w = cvt_pk_bf16(f[6], f[7]); return o; }
__device__ __forceinline__ void conv_item(Frame& F, int l, int item) {
    const int b = item >> 6, t0 = (item & 63) * 32, rowbase = b * SEQ, tid = fresh_tid(), lane = tid & 63, wave = __builtin_amdgcn_readfirstlane(tid >> 6);
    LAS float* U = (LAS float*)(F.lds + RING_OFF);
    for (int idx = tid; idx < 62 * 64; idx += NWAVES * 64) {
        const int rr = idx >> 6, c8 = (idx & 63) * 8, t = t0 - 30 + rr; float u[8];
        if (t >= 0) { const bf16* p = F.PROJ + (size_t)(rowbase + t) * NIN + c8; float a[8], g[8]; unpack8(*(const GAS v4u*)(p + C_CA), a); unpack8(*(const GAS v4u*)(p + C_CG), g);
#pragma unroll
            for (int j = 0; j < 8; ++j) u[j] = a[j] * pg8::sigmoidf_fast(g[j]); }
        else {
#pragma unroll
            for (int j = 0; j < 8; ++j) u[j] = 0.f; }
        LAS f32x4* d = (LAS f32x4*)(U + rr * 512 + c8); d[0] = (f32x4){u[0], u[1], u[2], u[3]}; d[1] = (f32x4){u[4], u[5], u[6], u[7]};
    }
    __syncthreads();
    const int c8 = lane * 8;
    {
        float acc[4][8];
        { const GAS f32x4* bp = (const GAS f32x4*)(F.conv_c_b + (size_t)l * DCF + c8); const f32x4 b0 = bp[0], b1 = bp[1];
#pragma unroll
          for (int j = 0; j < 4; ++j) { acc[j][0] = b0.x; acc[j][1] = b0.y; acc[j][2] = b0.z; acc[j][3] = b0.w; acc[j][4] = b1.x; acc[j][5] = b1.y; acc[j][6] = b1.z; acc[j][7] = b1.w; } }
        const float* wbase = F.conv_c_w + (size_t)l * CFW * DCF + c8;
#pragma unroll 1
        for (int k = 0; k < CFW; ++k) {
            const GAS f32x4* wp = (const GAS f32x4*)(wbase + (size_t)k * DCF); const f32x4 w0 = wp[0], w1 = wp[1];
#pragma unroll
            for (int j = 0; j < 4; ++j) { const LAS f32x4* up = (const LAS f32x4*)(U + (4 * wave + j + k) * 512 + c8); const f32x4 u0 = up[0], u1 = up[1];
                acc[j][0] += w0.x * u0.x; acc[j][1] += w0.y * u0.y; acc[j][2] += w0.z * u0.z; acc[j][3] += w0.w * u0.w;
                acc[j][4] += w1.x * u1.x; acc[j][5] += w1.y * u1.y; acc[j][6] += w1.z * u1.z; acc[j][7] += w1.w * u1.w; }
        }
        const GAS f32x4* gp = (const GAS f32x4*)(F.norm_c_g + (size_t)l * DCF + c8); const GAS f32x4* bp = (const GAS f32x4*)(F.norm_c_b + (size_t)l * DCF + c8);
        const f32x4 g0 = gp[0], g1 = gp[1], e0 = bp[0], e1 = bp[1];
        const float gg[8] = {g0.x, g0.y, g0.z, g0.w, g1.x, g1.y, g1.z, g1.w}, ee[8] = {e0.x, e0.y, e0.z, e0.w, e1.x, e1.y, e1.z, e1.w};
#pragma unroll
        for (int j = 0; j < 4; ++j) {
            float s = 0.f;
#pragma unroll
            for (int q = 0; q < 8; ++q) s += acc[j][q];
            const float mean = wave_sum(s) * (1.f / DCF); float qq = 0.f;
#pragma unroll
            for (int q = 0; q < 8; ++q) { acc[j][q] -= mean; qq += acc[j][q] * acc[j][q]; }
            const float rstd = 1.0f / sqrtf(wave_sum(qq) * (1.f / DCF) + LN_EPS); float o[8];
#pragma unroll
            for (int q = 0; q < 8; ++q) { const float y = acc[j][q] * rstd * gg[q] + ee[q]; o[q] = y * pg8::sigmoidf_fast(y); }
            *(GAS v4u*)(F.Z + (size_t)(rowbase + t0 + 4 * wave + j) * D + Z_C + c8) = pack8(o);
        }
    }
    {
        const GAS f32x4* wp = (const GAS f32x4*)(F.conv_a_w + (size_t)l * SCW * DSC + c8);
        float w[3][8];
#pragma unroll
        for (int k = 0; k < 3; ++k) { const f32x4 a = wp[k * (DSC / 4)], c = wp[k * (DSC / 4) + 1]; w[k][0] = a.x; w[k][1] = a.y; w[k][2] = a.z; w[k][3] = a.w; w[k][4] = c.x; w[k][5] = c.y; w[k][6] = c.z; w[k][7] = c.w; }
#pragma unroll
        for (int j = 0; j < 4; ++j) { const int t = t0 + 4 * wave + j; float o[8];
#pragma unroll
            for (int q = 0; q < 8; ++q) o[q] = 0.f;
#pragma unroll
            for (int k = 0; k < 3; ++k) { const int ts = t - 2 + k;
                if (ts >= 0) { const bf16* p = F.PROJ + (size_t)(rowbase + ts) * NIN + c8; float cc[8], uu[8]; unpack8(*(const GAS v4u*)(p + C_SC), cc); unpack8(*(const GAS v4u*)(p + C_SU), uu);
#pragma unroll
                    for (int q = 0; q < 8; ++q) o[q] += w[k][q] * (cc[q] * uu[q]); } }
            float bb[8]; unpack8(*(const GAS v4u*)(F.PROJ + (size_t)(rowbase + t) * NIN + C_SB + c8), bb);
#pragma unroll
            for (int q = 0; q < 8; ++q) o[q] *= bb[q];
            *(GAS v4u*)(F.Z + (size_t)(rowbase + t) * D + Z_A + c8) = pack8(o);
        }
    }
    __syncthreads();
}

__device__ __forceinline__ void attn_simple_item(Frame& F, int id) {
    const int lane = fresh_tid() & 63, bh = id >> 6, jj = id & 63, qc = (jj & 1) ? 63 - (jj >> 1) : (jj >> 1);
    const int b = bh >> 3, h = bh & 7, qi = lane & 31, half = lane >> 5, t = qc * 32 + qi;
    const bf16* base = F.PROJ + (size_t)(b * SEQ) * NIN + h * HD + half * 64;
    float q[64], o[64];
    { const GAS v4u* qp = (const GAS v4u*)(base + (size_t)t * NIN + C_Q);
#pragma unroll
      for (int i = 0; i < 8; ++i) { float f[8]; unpack8(qp[i], f);
#pragma unroll
          for (int j = 0; j < 8; ++j) q[8 * i + j] = f[j]; } }
#pragma unroll
    for (int i = 0; i < 64; ++i) o[i] = 0.f;
    float carry = 1.f;
#pragma unroll 1
    for (int s = qc * 32 + 30; s >= 0; --s) {
        const GAS v4u* kp = (const GAS v4u*)(base + (size_t)s * NIN + C_K); const GAS v4u* vp = (const GAS v4u*)(base + (size_t)s * NIN + C_V);
        float z0 = 0.f, z1 = 0.f;
#pragma unroll
        for (int i = 0; i < 8; ++i) { float f[8]; unpack8(kp[i], f);
#pragma unroll
            for (int j = 0; j < 8; j += 2) { z0 += q[8 * i + j] * f[j]; z1 += q[8 * i + j + 1] * f[j + 1]; } }
        float z = z0 + z1; z += __shfl_xor(z, 32);
        const float e = __builtin_amdgcn_exp2f(fminf(-z, 100.f)), sg = __builtin_amdgcn_rcpf(1.f + e);
        const bool act = s < t;
        const float a = act ? sg * carry : 0.f;
        carry = act ? carry * (e * sg) : carry;
#pragma unroll
        for (int i = 0; i < 8; ++i) { float f[8]; unpack8(vp[i], f);
#pragma unroll
            for (int j = 0; j < 8; ++j) o[8 * i + j] += a * f[j]; }
    }
    GAS v4u* op = (GAS v4u*)(F.Z + (size_t)(b * SEQ + t) * D + Z_B + h * HD + half * 64);
#pragma unroll
    for (int i = 0; i < 8; ++i) { float f[8];
#pragma unroll
        for (int j = 0; j < 8; ++j) f[j] = o[8 * i + j];
        op[i] = pack8(f); }
}

namespace sba {
typedef short bf16x8 __attribute__((ext_vector_type(8)));
typedef short s16x4 __attribute__((ext_vector_type(4)));
typedef float f32x16 __attribute__((ext_vector_type(16)));
constexpr int SHM = 16384;
constexpr int LDS_V = 0, LDS_K = 2 * SHM;
#define SBA_KSWZ(row, colB) ((row) * 256 + ((colB) ^ (((row) & 7) << 4)))
__device__ __forceinline__ int v_st(int k, int c) { const int kk = (k & ~0xC) | ((k & 4) << 1) | ((k & 8) >> 1); return ((kk >> 3) * 4 + (c >> 5)) * 512 + ((kk & 7) * 32 + (c & 31)) * 2; }
__device__ __forceinline__ int v_rd_base(int lane) { return ((lane & 3) << 3) | (((lane >> 2) & 3) << 6) | (((lane >> 4) & 1) << 5) | (((lane >> 5) & 1) << 8); }
constexpr int v_rd_off(int d0, int ks, int half) { return d0 * 512 + ks * 4096 + half * 2048; }
__device__ __forceinline__ int crow(int r, int hi) { return (r & 3) + 8 * (r >> 2) + 4 * hi; }
__device__ __forceinline__ unsigned cvtpk(float lo, float hi) { unsigned r; asm("v_cvt_pk_bf16_f32 %0, %1, %2" : "=v"(r) : "v"(lo), "v"(hi)); return r; }

__device__ __forceinline__ void qkt(f32x16& p0, f32x16& p1, const LAS unsigned char* Kb, int r32, int hi, const bf16x8* qr) {
    p0 = f32x16{}; p1 = f32x16{};
    const LAS unsigned char* kb[4];
#pragma unroll
    for (int dd = 0; dd < 4; ++dd) kb[dd] = Kb + SBA_KSWZ(r32, (dd * 16 + hi * 8) * 2);
#pragma unroll
    for (int d0 = 0; d0 < 8; ++d0) { const LAS unsigned char* a = kb[d0 & 3] + (d0 >> 2) * 128;
        const bf16x8 b0 = *(const LAS bf16x8*)a, b1 = *(const LAS bf16x8*)(a + 32 * 256);
        p0 = __builtin_amdgcn_mfma_f32_32x32x16_bf16(b0, qr[d0], p0, 0, 0, 0);
        p1 = __builtin_amdgcn_mfma_f32_32x32x16_bf16(b1, qr[d0], p1, 0, 0, 0); }
}
__device__ __forceinline__ void pv_tile(f32x16* o, int vb, bf16x8 pa0, bf16x8 pa1, bf16x8 pa2, bf16x8 pa3) {
#define SBA_TRRD(dst, off) asm volatile("ds_read_b64_tr_b16 %0, %1 offset:%2" : "=&v"(dst) : "v"(vb), "i"(off) : "memory")
#define SBA_PV_D0(d0) do { s16x4 l0, l1, l2, l3, h0, h1, h2, h3; constexpr int b_ = v_rd_off(d0, 0, 0); \
        SBA_TRRD(l0, b_); SBA_TRRD(h0, b_ + 2048); SBA_TRRD(l1, b_ + 4096); SBA_TRRD(h1, b_ + 6144); SBA_TRRD(l2, b_ + 8192); SBA_TRRD(h2, b_ + 10240); SBA_TRRD(l3, b_ + 12288); SBA_TRRD(h3, b_ + 14336); \
        asm volatile("s_waitcnt lgkmcnt(0)" ::: "memory"); __builtin_amdgcn_sched_barrier(0); \
        o[d0] = __builtin_amdgcn_mfma_f32_32x32x16_bf16(pa0, (bf16x8){l0[0], l0[1], l0[2], l0[3], h0[0], h0[1], h0[2], h0[3]}, o[d0], 0, 0, 0); \
        o[d0] = __builtin_amdgcn_mfma_f32_32x32x16_bf16(pa1, (bf16x8){l1[0], l1[1], l1[2], l1[3], h1[0], h1[1], h1[2], h1[3]}, o[d0], 0, 0, 0); \
        o[d0] = __builtin_amdgcn_mfma_f32_32x32x16_bf16(pa2, (bf16x8){l2[0], l2[1], l2[2], l2[3], h2[0], h2[1], h2[2], h2[3]}, o[d0], 0, 0, 0); \
        o[d0] = __builtin_amdgcn_mfma_f32_32x32x16_bf16(pa3, (bf16x8){l3[0], l3[1], l3[2], l3[3], h3[0], h3[1], h3[2], h3[3]}, o[d0], 0, 0, 0); } while (0)
    SBA_PV_D0(0); SBA_PV_D0(1); SBA_PV_D0(2); SBA_PV_D0(3);
#undef SBA_PV_D0
#undef SBA_TRRD
}
template <bool MASK>
__device__ __forceinline__ void stick(f32x16& p0, f32x16& p1, float& carry, int dq, bool hi, bf16x8& pa0, bf16x8& pa1, bf16x8& pa2, bf16x8& pa3) {
    float gp[8];
#pragma unroll
    for (int idx = 0; idx < 8; ++idx) { const int g = idx & 3; f32x16& p = (idx >> 2) ? p1 : p0; float sg[4], f[4];
#pragma unroll
        for (int i = 0; i < 4; ++i) { const float e = __builtin_amdgcn_exp2f(-p[4 * g + i]); float s_ = __builtin_amdgcn_rcpf(1.0f + e);
            if (MASK) s_ = ((8 * g + i + 32 * (idx >> 2)) < dq) ? s_ : 0.f;
            sg[i] = s_; f[i] = 1.0f - s_; }
        const float x2 = f[3], x1 = x2 * f[2], x0 = x1 * f[1];
        gp[idx] = x0 * f[0];
        p[4 * g + 3] = sg[3]; p[4 * g + 2] = sg[2] * x2; p[4 * g + 1] = sg[1] * x1; p[4 * g + 0] = sg[0] * x0; }
    float S = carry, E[8];
#pragma unroll
    for (int idx = 7; idx >= 0; --idx) {
        const auto rr = __builtin_amdgcn_permlane32_swap(__float_as_uint(gp[idx]), __float_as_uint(gp[idx]), false, false);
        const float glo = __uint_as_float(rr[0]), ghi = __uint_as_float(rr[1]);
        const float Ehi = S; S *= ghi; const float Elo = S; S *= glo;
        E[idx] = hi ? Ehi : Elo; }
    carry = S;
#pragma unroll
    for (int idx = 0; idx < 8; ++idx) { const int g = idx & 3; f32x16& p = (idx >> 2) ? p1 : p0;
#pragma unroll
        for (int i = 0; i < 4; ++i) p[4 * g + i] *= E[idx]; }
#define SBA_PK4(P, B_, OUT) do { unsigned a0 = cvtpk(P[B_ + 0], P[B_ + 1]), a1 = cvtpk(P[B_ + 2], P[B_ + 3]), b0 = cvtpk(P[B_ + 4], P[B_ + 5]), b1 = cvtpk(P[B_ + 6], P[B_ + 7]); \
        auto r0 = __builtin_amdgcn_permlane32_swap(a0, b0, false, false); auto r1 = __builtin_amdgcn_permlane32_swap(a1, b1, false, false); \
        v4u w = {r0[0], r1[0], r0[1], r1[1]}; OUT = __builtin_bit_cast(bf16x8, w); } while (0)
    SBA_PK4(p0, 0, pa0); SBA_PK4(p0, 8, pa1); SBA_PK4(p1, 0, pa2); SBA_PK4(p1, 8, pa3);
#undef SBA_PK4
}
__device__ __forceinline__ void attn_item(const bf16* PROJ, bf16* Z, LAS unsigned char* lds, int item) {
    const int tid = fresh_tid(), wid = __builtin_amdgcn_readfirstlane(tid >> 6), lane = tid & 63, r32 = lane & 31, hi = lane >> 5;
    const int bh = item >> 3, qb = 7 - (item & 7), b = bh >> 3, h = bh & 7;
    const bf16* base = PROJ + (size_t)(b * SEQ) * NIN + h * HD;
    const int T0 = qb * 256 + wid * 32;
    bf16x8 qr[8];
#pragma unroll
    for (int d0 = 0; d0 < 8; ++d0) qr[d0] = *(const GAS bf16x8*)(base + (size_t)(T0 + r32) * NIN + C_Q + d0 * 16 + hi * 8);
    const int sr = tid >> 4, sc = (tid & 15) * 8, vst0 = v_st(sr, sc), vst1 = v_st(32 + sr, sc), kws = SBA_KSWZ(sr, sc * 2);
    const int vb0 = (int)(uintptr_t)(lds + LDS_V) + v_rd_base(lane);
    const int NT = 4 * qb + 4;
    bf16x8 st_k0, st_k1, st_v0, st_v1;
#define SBA_LOAD(j) do { const bf16* rp = base + (size_t)((j) * 64 + sr) * NIN + sc; \
        st_k0 = *(const GAS bf16x8*)(rp + C_K); st_k1 = *(const GAS bf16x8*)(rp + (size_t)32 * NIN + C_K); st_v0 = *(const GAS bf16x8*)(rp + C_V); st_v1 = *(const GAS bf16x8*)(rp + (size_t)32 * NIN + C_V); } while (0)
#define SBA_WRITE(bf) do { *(LAS bf16x8*)(lds + LDS_K + (bf) * SHM + kws) = st_k0; *(LAS bf16x8*)(lds + LDS_K + (bf) * SHM + kws + 32 * 256) = st_k1; \
        *(LAS bf16x8*)(lds + LDS_V + (bf) * SHM + vst0) = st_v0; *(LAS bf16x8*)(lds + LDS_V + (bf) * SHM + vst1) = st_v1; } while (0)
    SBA_LOAD(NT - 1); SBA_WRITE(0);
    __syncthreads();
    f32x16 o[4] = {}; float carry = 1.0f;
    for (int tt = 0; tt < NT; ++tt) {
        const int j = NT - 1 - tt, cur = tt & 1, kb = j * 64;
        if (tt + 1 < NT) SBA_LOAD(j - 1);
        if (kb <= T0 + 30) {
            f32x16 p0, p1; bf16x8 pa0, pa1, pa2, pa3;
            qkt(p0, p1, lds + LDS_K + cur * SHM, r32, hi, qr);
            if (kb + 63 >= T0) stick<true>(p0, p1, carry, T0 + r32 - kb - 4 * hi, hi != 0, pa0, pa1, pa2, pa3);
            else stick<false>(p0, p1, carry, 0, hi != 0, pa0, pa1, pa2, pa3);
            pv_tile(o, vb0 + cur * SHM, pa0, pa1, pa2, pa3);
        }
        if (tt + 1 < NT) SBA_WRITE(cur ^ 1);
        __syncthreads();
    }
#undef SBA_LOAD
#undef SBA_WRITE
    bf16* Ow = Z + (size_t)(b * SEQ + T0) * D + Z_B + h * HD;
#pragma unroll
    for (int r = 0; r < 16; ++r) { const int orow = crow(r, hi);
#pragma unroll
        for (int d0 = 0; d0 < 4; ++d0) { const float v = o[d0][r], vn = __shfl_xor(v, 1);
            if ((r32 & 1) == 0) *(GAS unsigned*)(Ow + (size_t)orow * D + d0 * 32 + r32) = cvtpk(v, vn); } }
}
}

struct Args { const float* in[17]; float* out; unsigned char* ws; int l_lo, l_hi, ph_lo, ph_hi; };
constexpr int NPH = 9;
__global__ void __launch_bounds__(NWAVES * 64, 2) mega_fwd(Args args) {
    extern __shared__ __attribute__((aligned(16))) unsigned char lds[];
    Frame F;
    F.lds = (LAS unsigned char*)lds;
    F.G = gridDim.x; { const int bx = blockIdx.x; F.vcu = (F.G % 8 == 0) ? (bx % 8) * (F.G / 8) + bx / 8 : bx; }
    F.x = args.in[0]; F.ln_mix_pre = args.in[1]; F.ln_mix_post = args.in[2]; F.ln_mlp_pre = args.in[3]; F.ln_mlp_post = args.in[4]; F.w_in = args.in[5]; F.conv_a_w = args.in[6];
    F.proj_a = args.in[7]; F.proj_b = args.in[8]; F.conv_c_w = args.in[9]; F.conv_c_b = args.in[10]; F.norm_c_g = args.in[11]; F.norm_c_b = args.in[12]; F.proj_c = args.in[13];
    F.w_o = args.in[14]; F.w_up = args.in[15]; F.w_down = args.in[16]; F.out = args.out; F.ws = args.ws;
    F.H = (bf16*)(F.ws + WS_H); F.PROJ = (bf16*)(F.ws + WS_PROJ); F.Z = (bf16*)(F.ws + WS_Z); F.MIX = (bf16*)(F.ws + WS_MIX); F.F = (bf16*)(F.ws + WS_F); F.Y = (float*)(F.ws + WS_Y);
    gu32* ctl = (gu32*)(F.ws + WS_CTL);
    for (int u = threadIdx.x; u < (LDS_BYTES - LDSCTL_OFF) / 4; u += NWAVES * 64) ((LAS unsigned*)(F.lds + LDSCTL_OFF))[u] = 0u;
    __syncthreads();
#if MK_MULTI
#define SEAM() do { } while (0)
#else
    XcdBarrier bar = xcd_barrier_post((unsigned*)(ctl + CW_BAR), (volatile LAS unsigned*)(F.lds + MISC_OFF) + 8);
#define SEAM() xcd_barrier(bar)
#endif
    const int lo = args.ph_lo, hi = args.ph_hi;
#define IN(k) (lo <= (k) && (k) < hi)
    for (int l = args.l_lo; l < args.l_hi; ++l) {
        if (l == 0 && IN(0)) {
#if !MK_SKEL && ((PH_MASK >> 0) & 1)
            p0_prologue(F);
#endif
            SEAM();
        }
        if (IN(1)) {
#if !MK_SKEL && ((PH_MASK >> 1) & 1)
            pg8::Gemm g{F.H, wl(F, l, WL_IN), M, NIN, D}; pg8::StaticOrder S; S.init(M, NIN, F.G, (int)blockIdx.x);
            pg8::EpiIn E{F.PROJ};
            pg8::gemm_phase<pg8::EpiIn, pg8::StaticOrder, true, true>(F.lds + RING_OFF, g, S, E);
#endif
            SEAM();
        }
        if (IN(2)) {
#if !MK_SKEL && ((PH_MASK >> 2) & 1)
            for (int it = F.vcu; it < BATCH * (SEQ / 32); it += F.G) conv_item(F, l, it);
#if ATTN_SIMPLE
            for (int id = F.vcu * NWAVES + __builtin_amdgcn_readfirstlane(fresh_tid() >> 6); id < BATCH * NHEAD * (SEQ / 32); id += F.G * NWAVES) attn_simple_item(F, id);
#else
            for (int it = F.vcu; it < BATCH * NHEAD * (SEQ / 256); it += F.G) sba::attn_item(F.PROJ, F.Z, F.lds + RING_OFF, it);
#endif
#endif
            SEAM();
        }
        if (IN(3)) {
#if !MK_SKEL && ((PH_MASK >> 3) & 1)
            pg8::Gemm g{F.Z, wl(F, l, WL_PABC), M, D, D}; pg8::StaticOrder S; S.init(M, D, F.G, (int)blockIdx.x);
            pg8::EpiMix E{F.MIX, F.PROJ + C_G};
            pg8::gemm_phase<pg8::EpiMix, pg8::StaticOrder, true, true>(F.lds + RING_OFF, g, S, E);
#endif
            SEAM();
        }
        if (IN(4)) {
#if !MK_SKEL && ((PH_MASK >> 4) & 1)
            pg8::Gemm g{F.MIX, wl(F, l, WL_O), M, D, D}; pg8::StaticOrder S; S.init(M, D, F.G, (int)blockIdx.x);
            pg8::EpiF32 E{F.Y, D};
            pg8::gemm_phase<pg8::EpiF32, pg8::StaticOrder, true, true>(F.lds + RING_OFF, g, S, E);
#endif
            SEAM();
        }
        if (IN(5)) {
#if !MK_SKEL && ((PH_MASK >> 5) & 1)
            norm_phase(F, l == 0 ? F.x : F.out, F.ln_mix_post + (size_t)l * D, F.ln_mlp_pre + (size_t)l * D);
#endif
            SEAM();
        }
        if (IN(6)) {
#if !MK_SKEL && ((PH_MASK >> 6) & 1)
            pg8::Gemm g{F.H, wl(F, l, WL_UP), M, DFF, D}; pg8::StaticOrder S; S.init(M, DFF, F.G, (int)blockIdx.x);
            pg8::EpiRelu2 E{F.F, DFF};
            pg8::gemm_phase<pg8::EpiRelu2, pg8::StaticOrder, true, true>(F.lds + RING_OFF, g, S, E);
#endif
            SEAM();
        }
        if (IN(7)) {
#if !MK_SKEL && ((PH_MASK >> 7) & 1)
            pg8::Gemm g{F.F, wl(F, l, WL_DOWN), M, D, DFF}; pg8::StaticOrder S; S.init(M, D, F.G, (int)blockIdx.x);
            pg8::EpiF32 E{F.Y, D};
            pg8::gemm_phase<pg8::EpiF32, pg8::StaticOrder, true, true>(F.lds + RING_OFF, g, S, E);
#endif
            SEAM();
        }
        if (IN(8)) {
#if !MK_SKEL && ((PH_MASK >> 8) & 1)
            norm_phase(F, F.out, F.ln_mlp_post + (size_t)l * D, (l + 1 < DEPTH) ? F.ln_mix_pre + (size_t)(l + 1) * D : nullptr);
#endif
            if (l + 1 < DEPTH) SEAM();
        }
    }
#undef IN
}

extern "C" void kernel_launch(void* const* d_in, const int* in_sizes, int n_in, void* d_out, int out_size, void* d_ws, size_t ws_size, hipStream_t stream) {
    static int grid = 0;
    if (grid == 0) {
        if (n_in != 17 || in_sizes[0] != M * D || out_size != M * D || ws_size < WS_END) { fprintf(stderr, "kernel_launch: unexpected shapes (n_in %d, in0 %d, out %d, ws %zu < %zu)\n", n_in, n_in > 0 ? in_sizes[0] : -1, out_size, ws_size, (size_t)WS_END); grid = -1; return; }
        int dev = 0, cus = 0, per_cu = 0;
        if (hipGetDevice(&dev) != hipSuccess || hipDeviceGetAttribute(&cus, hipDeviceAttributeMultiprocessorCount, dev) != hipSuccess) { grid = -1; return; }
        if (hipFuncSetAttribute((const void*)mega_fwd, hipFuncAttributeMaxDynamicSharedMemorySize, LDS_BYTES) != hipSuccess) { fprintf(stderr, "kernel_launch: hipFuncSetAttribute failed\n"); grid = -1; return; }
        if (hipOccupancyMaxActiveBlocksPerMultiprocessor(&per_cu, (const void*)mega_fwd, NWAVES * 64, LDS_BYTES) != hipSuccess || per_cu < 1) { fprintf(stderr, "kernel_launch: occupancy query says %d\n", per_cu); (void)hipGetLastError(); per_cu = 1; }
        grid = cus;
    }
    if (grid < 0) return;
    if (hipMemsetAsync((char*)d_ws + WS_CTL, 0, CTL_ZERO_BYTES, stream) != hipSuccess) return;
    Args a{};
    for (int i = 0; i < 17; ++i) a.in[i] = (const float*)d_in[i];
    a.out = (float*)d_out; a.ws = (unsigned char*)d_ws;
#if MK_MULTI
    for (int l = 0; l < DEPTH; ++l)
        for (int p = (l == 0 ? 0 : 1); p < NPH; ++p) { a.l_lo = l; a.l_hi = l + 1; a.ph_lo = p; a.ph_hi = p + 1; hipLaunchKernelGGL(mega_fwd, dim3(grid), dim3(NWAVES * 64), LDS_BYTES, stream, a); }
#else
    a.l_lo = 0; a.l_hi = DEPTH; a.ph_lo = 0; a.ph_hi = NPH;
    hipLaunchKernelGGL(mega_fwd, dim3(grid), dim3(NWAVES * 64), LDS_BYTES, stream, a);
#endif
}
```

```cpp
#include <hip/hip_runtime.h>
#include <cstdio>
#include <cstdint>

#ifndef MK_MULTI
#define MK_MULTI 0
#endif
#ifndef PH_MASK
#define PH_MASK 0x1ff
#endif
#ifndef PROBE_DUP
#define PROBE_DUP 0
#endif
#ifndef ATTN_SIMPLE
#define ATTN_SIMPLE 0
#endif
#ifndef MK_SKEL
#define MK_SKEL 0
#endif

constexpr int D = 2048, BATCH = 4, SEQ = 2048, DEPTH = 4, M = BATCH * SEQ;
constexpr int HD = 128, DATT = 1024, NHEAD = 8, DSC = 512, DCF = 512, DFF = 8192, NIN = 11776;
constexpr int SCW = 3, CFW = 31;
constexpr float RMS_EPS = 1e-6f, LN_EPS = 1e-5f;
constexpr int C_Q = 0, C_K = 1024, C_V = 2048, C_SB = 3072, C_SC = 3584, C_SU = 4096, C_CA = 4608, C_CG = 5120, C_G = 5632;
constexpr int Z_A = 0, Z_B = 512, Z_C = 1536;
constexpr float QSCALE = 0.08838834764831845f * 1.4426950408889634f;

namespace pg8 {
#define PG8_LAS __attribute__((address_space(3)))
typedef unsigned short bf16_t;
typedef short bf16x8 __attribute__((ext_vector_type(8)));
typedef float f32x4 __attribute__((ext_vector_type(4)));
typedef unsigned u32x4 __attribute__((ext_vector_type(4)));
constexpr int BM = 256, BK = 64, HALF = 128, HTB = HALF * BK * 2, STAGE_BYTES = 8 * HTB, NXCD = 8, WGM = 8;

__host__ __device__ __forceinline__ int lds_byte(int r, int c) { const int st = (r >> 4) * 2 + (c >> 5), rr = r & 15, cc = c & 31, ob = rr * 64 + cc * 2; return st * 1024 + (ob ^ (((ob >> 9) & 1) << 5)); }
__host__ __device__ __forceinline__ void stage_rc(int b, int& R, int& C) { const int st = b / 1024, sb = b % 1024, swz = sb ^ (((sb >> 9) & 1) << 5); R = (st >> 1) * 16 + swz / 64; C = (st & 1) * 32 + (swz % 64) / 2; }
__host__ __device__ __forceinline__ int perm32(int rho) { const int n = rho >> 4, i = rho & 15; return 8 * (i >> 2) + 4 * n + (i & 3); }

struct Unit { int pm, pn; };
struct Gemm { const bf16_t* A; const bf16_t* Bt; int M, N, K; };

struct StaticOrder {
    int nM, nN, nwg, G, c;
    __host__ __device__ void init(int M_, int N_, int G_, int c_) { nM = M_ / BM; nN = N_ / BM; nwg = nM * nN; G = G_; c = c_; }
    __host__ __device__ bool next(int i, Unit& u) const {
        const long L = (long)i * G + c; if (L >= nwg) return false;
        int wgid = (int)L; { const int q = nwg / NXCD, r = nwg % NXCD, xcd = wgid % NXCD, off = wgid / NXCD; wgid = (xcd < r ? xcd * (q + 1) : r * (q + 1) + (xcd - r) * q) + off; }
        const int nig = WGM * nN, gid = wgid / nig, fm = gid * WGM, gsz = (nM - fm) < WGM ? (nM - fm) : WGM;
        u.pm = fm + ((wgid % nig) % gsz); u.pn = (wgid % nig) / gsz; return true;
    }
    __device__ __forceinline__ void a_ready(const Unit&) const {}
    __device__ __forceinline__ void done(const Unit&) const {}
};

__device__ __forceinline__ unsigned cvt_pk_bf16(float lo, float hi) { unsigned r; asm volatile("v_cvt_pk_bf16_f32 %0, %1, %2" : "=v"(r) : "v"(lo), "v"(hi)); return r; }
__device__ __forceinline__ float bf_lo(unsigned w) { return __uint_as_float(w << 16); }
__device__ __forceinline__ float bf_hi(unsigned w) { return __uint_as_float(w & 0xffff0000u); }
__device__ __forceinline__ float sigmoidf_fast(float x) { return __builtin_amdgcn_rcpf(1.0f + __builtin_amdgcn_exp2f(-1.4426950408889634f * x)); }


struct EpiIn {
    static constexpr bool PERM = true, AFTER_DRAIN = false, SEG = false; static constexpr int T1 = -1, T2 = -1;
    bf16_t* O;
    __device__ __forceinline__ void rescale(f32x4 (&)[2][2][4][2], const Unit&, int, int, int, int, int) const {}
    __device__ __forceinline__ void operator()(const f32x4 (&acc)[2][2][4][2], const Unit& u, int wr, int wc, int fr, int fq) const {
        const int row0 = u.pm * BM + wr * 64 + fr, col0 = u.pn * BM + wc * 32 + 8 * fq;
        const int mode = (u.pn < 4) ? 1 : ((u.pn >= 22) ? 2 : 0);
#pragma unroll
        for (int ai = 0; ai < 2; ++ai)
#pragma unroll
            for (int m = 0; m < 4; ++m) { bf16_t* rowp = O + (size_t)(row0 + ai * HALF + m * 16) * NIN + col0;
#pragma unroll
                for (int bj = 0; bj < 2; ++bj) { f32x4 v0 = acc[ai][bj][m][0], v1 = acc[ai][bj][m][1];
                    if (mode == 1) { v0 = v0 * QSCALE; v1 = v1 * QSCALE; }
                    if (mode == 2) {
#pragma unroll
                        for (int j = 0; j < 4; ++j) { v0[j] = fmaxf(sigmoidf_fast(v0[j]), 1e-30f); v1[j] = fmaxf(sigmoidf_fast(v1[j]), 1e-30f); } }
                    u32x4 w; w.x = cvt_pk_bf16(v0[0], v0[1]); w.y = cvt_pk_bf16(v0[2], v0[3]); w.z = cvt_pk_bf16(v1[0], v1[1]); w.w = cvt_pk_bf16(v1[2], v1[3]);
                    *(u32x4*)(rowp + bj * HALF) = w; } }
    }
};
struct EpiMix {
    static constexpr bool PERM = true, AFTER_DRAIN = false, SEG = true; static constexpr int T1 = 8, T2 = 24;
    bf16_t* O; const bf16_t* G;
    __device__ __forceinline__ void rescale(f32x4 (&acc)[2][2][4][2], const Unit& u, int t, int wr, int wc, int fr, int fq) const {
        const unsigned loff = (unsigned)(fr * NIN + 8 * fq) * 2u;
        const char* ub = (const char*)G + ((size_t)(u.pm * BM + wr * 64) * NIN + u.pn * BM + wc * 32 + (t == T1 ? 0 : D)) * 2;
#pragma unroll
        for (int ai = 0; ai < 2; ++ai)
#pragma unroll
            for (int m = 0; m < 4; ++m) { const char* gp = ub + (size_t)(ai * HALF + m * 16) * NIN * 2;
#pragma unroll
                for (int bj = 0; bj < 2; ++bj) { const u32x4 nu = *(const u32x4*)(gp + bj * HALF * 2 + loff), de = *(const u32x4*)(gp + (D + bj * HALF) * 2 + loff);
                    f32x4 r0, r1;
                    r0[0] = bf_lo(nu.x) * __builtin_amdgcn_rcpf(bf_lo(de.x)); r0[1] = bf_hi(nu.x) * __builtin_amdgcn_rcpf(bf_hi(de.x));
                    r0[2] = bf_lo(nu.y) * __builtin_amdgcn_rcpf(bf_lo(de.y)); r0[3] = bf_hi(nu.y) * __builtin_amdgcn_rcpf(bf_hi(de.y));
                    r1[0] = bf_lo(nu.z) * __builtin_amdgcn_rcpf(bf_lo(de.z)); r1[1] = bf_hi(nu.z) * __builtin_amdgcn_rcpf(bf_hi(de.z));
                    r1[2] = bf_lo(nu.w) * __builtin_amdgcn_rcpf(bf_lo(de.w)); r1[3] = bf_hi(nu.w) * __builtin_amdgcn_rcpf(bf_hi(de.w));
                    acc[ai][bj][m][0] = acc[ai][bj][m][0] * r0; acc[ai][bj][m][1] = acc[ai][bj][m][1] * r1; }
                if (m & 1) asm volatile("" ::: "memory"); }
    }
    __device__ __forceinline__ void operator()(const f32x4 (&acc)[2][2][4][2], const Unit& u, int wr, int wc, int fr, int fq) const {
        const int row0 = u.pm * BM + wr * 64 + fr, col0 = u.pn * BM + wc * 32 + 8 * fq;
#pragma unroll
        for (int ai = 0; ai < 2; ++ai)
#pragma unroll
            for (int m = 0; m < 4; ++m) { const size_t r = (size_t)(row0 + ai * HALF + m * 16); const bf16_t* gp = G + r * NIN + 2 * D + col0; bf16_t* rowp = O + r * D + col0;
#pragma unroll
                for (int bj = 0; bj < 2; ++bj) { const u32x4 g = *(const u32x4*)(gp + bj * HALF); f32x4 v0 = acc[ai][bj][m][0], v1 = acc[ai][bj][m][1];
                    v0[0] *= bf_lo(g.x); v0[1] *= bf_hi(g.x); v0[2] *= bf_lo(g.y); v0[3] *= bf_hi(g.y); v1[0] *= bf_lo(g.z); v1[1] *= bf_hi(g.z); v1[2] *= bf_lo(g.w); v1[3] *= bf_hi(g.w);
                    u32x4 w; w.x = cvt_pk_bf16(v0[0], v0[1]); w.y = cvt_pk_bf16(v0[2], v0[3]); w.z = cvt_pk_bf16(v1[0], v1[1]); w.w = cvt_pk_bf16(v1[2], v1[3]);
                    *(u32x4*)(rowp + bj * HALF) = w; }
                if (m & 1) asm volatile("" ::: "memory"); }
    }
};
struct EpiF32 {
    static constexpr bool PERM = false, AFTER_DRAIN = false, SEG = false; static constexpr int T1 = -1, T2 = -1;
    float* C; int ldc;
    __device__ __forceinline__ void rescale(f32x4 (&)[2][2][4][2], const Unit&, int, int, int, int, int) const {}
    __device__ __forceinline__ void operator()(const f32x4 (&acc)[2][2][4][2], const Unit& u, int wr, int wc, int fr, int fq) const {
        const int row0 = u.pm * BM + wr * 64 + fr, col0 = u.pn * BM + wc * 32 + 4 * fq;
#pragma unroll
        for (int ai = 0; ai < 2; ++ai)
#pragma unroll
            for (int m = 0; m < 4; ++m) { float* rowp = C + (size_t)(row0 + ai * HALF + m * 16) * ldc + col0;
#pragma unroll
                for (int bj = 0; bj < 2; ++bj)
#pragma unroll
                    for (int n = 0; n < 2; ++n) *(f32x4*)(rowp + bj * HALF + n * 16) = acc[ai][bj][m][n]; }
    }
};
struct EpiRelu2 {
    static constexpr bool PERM = true, AFTER_DRAIN = false, SEG = false; static constexpr int T1 = -1, T2 = -1;
    bf16_t* O; int ldc;
    __device__ __forceinline__ void rescale(f32x4 (&)[2][2][4][2], const Unit&, int, int, int, int, int) const {}
    __device__ __forceinline__ void operator()(const f32x4 (&acc)[2][2][4][2], const Unit& u, int wr, int wc, int fr, int fq) const {
        const int row0 = u.pm * BM + wr * 64 + fr, col0 = u.pn * BM + wc * 32 + 8 * fq;
#pragma unroll
        for (int ai = 0; ai < 2; ++ai)
#pragma unroll
            for (int m = 0; m < 4; ++m) { bf16_t* rowp = O + (size_t)(row0 + ai * HALF + m * 16) * ldc + col0;
#pragma unroll
                for (int bj = 0; bj < 2; ++bj) { f32x4 v0 = acc[ai][bj][m][0], v1 = acc[ai][bj][m][1];
#pragma unroll
                    for (int j = 0; j < 4; ++j) { const float a = fmaxf(v0[j], 0.f), b = fmaxf(v1[j], 0.f); v0[j] = a * a; v1[j] = b * b; }
                    u32x4 w; w.x = cvt_pk_bf16(v0[0], v0[1]); w.y = cvt_pk_bf16(v0[2], v0[3]); w.z = cvt_pk_bf16(v1[0], v1[1]); w.w = cvt_pk_bf16(v1[2], v1[3]);
                    *(u32x4*)(rowp + bj * HALF) = w; } }
    }
};

template <class Epi, class Sched, bool ALIGN_EPI = false, bool SP2 = false>
__device__ __forceinline__ void gemm_phase(PG8_LAS unsigned char* lds, const Gemm g, const Sched& S, const Epi& E) {
    int tid_ = threadIdx.x; asm volatile("" : "+v"(tid_));
    const int tid = tid_, wid = __builtin_amdgcn_readfirstlane(tid >> 6), lane = tid & 63, wr = wid >> 2, wc = wid & 3, fr = lane & 15, fq = lane >> 4;
    const int K = g.K, nt = K / BK;
    unsigned voffA[2], voffB[2];
#pragma unroll
    for (int i = 0; i < 2; ++i) { int R, C; stage_rc(tid * 16 + i * 8192, R, C); const int Rb = Epi::PERM ? ((R & ~31) + perm32(R & 31)) : R;
        voffA[i] = (unsigned)(R * K + C) * 2u; voffB[i] = (unsigned)(Rb * K + C) * 2u; }
    const size_t kstep = (size_t)(BK * 2);
    const size_t hstep = (size_t)HALF * K * 2;
    const size_t tstep = 2 * hstep;
    const unsigned ldsw = (unsigned)wid * 1024u;
    const int aoff = lds_byte(wr * 64 + fr, fq * 8), boff = lds_byte(wc * 32 + fr, fq * 8);
#define PG8_SA(b, h) (((b) * 2 + (h)) * HTB)
#define PG8_SB(b, h) ((4 + (b) * 2 + (h)) * HTB)
#define PG8_STAGE(bufoff, gbase, voff) do { _Pragma("unroll") for (int _i = 0; _i < 2; ++_i) \
        __builtin_amdgcn_global_load_lds((const unsigned*)((const char*)(gbase) + (voff)[_i]), (PG8_LAS unsigned*)(lds + (bufoff) + ldsw + _i * 8192), 16, 0, 0); } while (0)
#define PG8_LDA(dst, b, h) do { _Pragma("unroll") for (int m = 0; m < 4; ++m) _Pragma("unroll") for (int k = 0; k < 2; ++k) dst[m][k] = *(const PG8_LAS bf16x8*)(lds + PG8_SA(b, h) + aoff + m * 2048 + k * 1024); } while (0)
#define PG8_LDB(dst, b, h) do { _Pragma("unroll") for (int n = 0; n < 2; ++n) _Pragma("unroll") for (int k = 0; k < 2; ++k) dst[n][k] = *(const PG8_LAS bf16x8*)(lds + PG8_SB(b, h) + boff + n * 2048 + k * 1024); } while (0)
#define PG8_MMA(ai, bj, At, Bt) do { __builtin_amdgcn_s_setprio(1); _Pragma("unroll") for (int m = 0; m < 4; ++m) _Pragma("unroll") for (int n = 0; n < 2; ++n) _Pragma("unroll") for (int k = 0; k < 2; ++k) \
        acc[ai][bj][m][n] = __builtin_amdgcn_mfma_f32_16x16x32_bf16(Bt[n][k], At[m][k], acc[ai][bj][m][n], 0, 0, 0); __builtin_amdgcn_s_setprio(0); } while (0)
#define PG8_WAIT_V(n) asm volatile("s_waitcnt vmcnt(" #n ")" ::: "memory")
#define PG8_WAIT_L(n) asm volatile("s_waitcnt lgkmcnt(" #n ")" ::: "memory")
#define PG8_BAR __builtin_amdgcn_s_barrier()
#define PG8_SCHED __builtin_amdgcn_sched_barrier(0)
    Unit cur, nxt; int ui = 0;
    if (!S.next(0, cur)) return;
    f32x4 acc[2][2][4][2];
#pragma unroll
    for (int a = 0; a < 2; ++a)
#pragma unroll
        for (int b = 0; b < 2; ++b)
#pragma unroll
            for (int m = 0; m < 4; ++m)
#pragma unroll
                for (int n = 0; n < 2; ++n) acc[a][b][m][n] = (f32x4){0.f, 0.f, 0.f, 0.f};
    bf16x8 At[4][2], B0[2][2], B1[2][2];
    const char* cA = (const char*)g.A + (size_t)cur.pm * tstep; const char* cB = (const char*)g.Bt + (size_t)cur.pn * tstep;
    S.a_ready(cur);
    if constexpr (SP2) {
        PG8_STAGE(PG8_SB(0, 0), cB, voffB); PG8_STAGE(PG8_SB(0, 1), cB + hstep, voffB); PG8_STAGE(PG8_SA(0, 0), cA, voffA); PG8_STAGE(PG8_SA(0, 1), cA + hstep, voffA);
        if (wr == 1) PG8_BAR;
        PG8_WAIT_V(2); PG8_BAR;
        PG8_STAGE(PG8_SB(1, 0), cB + kstep, voffB); PG8_STAGE(PG8_SA(1, 0), cA + kstep, voffA); PG8_STAGE(PG8_SB(1, 1), cB + hstep + kstep, voffB);
        PG8_WAIT_V(6); PG8_BAR;
    } else {
        PG8_STAGE(PG8_SB(0, 0), cB, voffB); PG8_STAGE(PG8_SA(0, 0), cA, voffA); PG8_STAGE(PG8_SB(0, 1), cB + hstep, voffB); PG8_STAGE(PG8_SA(0, 1), cA + hstep, voffA);
        if (wr == 1) PG8_BAR;
        PG8_WAIT_V(4); PG8_BAR;
        PG8_STAGE(PG8_SB(1, 0), cB + kstep, voffB); PG8_STAGE(PG8_SA(1, 0), cA + kstep, voffA); PG8_STAGE(PG8_SB(1, 1), cB + hstep + kstep, voffB);
        PG8_WAIT_V(6); PG8_BAR;
    }
    for (;;) {
        const bool has_next = S.next(ui + 1, nxt);
        const char* nA = has_next ? (const char*)g.A + (size_t)nxt.pm * tstep : cA; const char* nB = has_next ? (const char*)g.Bt + (size_t)nxt.pn * tstep : cB;
        for (int t = 0; t < nt; t += 2) {
            const bool last = (t == nt - 2);
            if constexpr (Epi::SEG) { if (t == Epi::T1 || t == Epi::T2) E.rescale(acc, cur, t, wr, wc, fr, fq); }
            const char* a1 = cA + (size_t)(t + 1) * kstep;
            const char* a2 = last ? nA : cA + (size_t)(t + 2) * kstep; const char* b2 = last ? nB : cB + (size_t)(t + 2) * kstep;
            const char* a3 = a2 + kstep; const char* b3 = b2 + kstep;
            if (last && has_next) S.a_ready(nxt);
            if constexpr (SP2) {
            PG8_LDB(B0, 0, 0); PG8_LDB(B1, 0, 1); PG8_SCHED; PG8_LDA(At, 0, 0); PG8_STAGE(PG8_SA(1, 1), a1 + hstep, voffA);
            PG8_WAIT_V(8); PG8_WAIT_L(0); PG8_BAR; PG8_MMA(0, 0, At, B0); PG8_MMA(0, 1, At, B1); PG8_BAR; PG8_SCHED;
            PG8_LDA(At, 0, 1); PG8_STAGE(PG8_SB(0, 0), b2, voffB); PG8_STAGE(PG8_SB(0, 1), b2 + hstep, voffB); PG8_STAGE(PG8_SA(0, 0), a2, voffA);
            PG8_WAIT_V(8); PG8_WAIT_L(0); PG8_BAR; PG8_MMA(1, 0, At, B0); PG8_MMA(1, 1, At, B1); PG8_BAR; PG8_SCHED;
            PG8_LDB(B0, 1, 0); PG8_LDB(B1, 1, 1); PG8_SCHED; PG8_LDA(At, 1, 0); PG8_STAGE(PG8_SA(0, 1), a2 + hstep, voffA);
            PG8_WAIT_V(8); PG8_WAIT_L(0); PG8_BAR; PG8_MMA(0, 0, At, B0); PG8_MMA(0, 1, At, B1); PG8_BAR; PG8_SCHED;
            PG8_LDA(At, 1, 1); PG8_STAGE(PG8_SB(1, 0), b3, voffB); PG8_STAGE(PG8_SB(1, 1), b3 + hstep, voffB); PG8_STAGE(PG8_SA(1, 0), a3, voffA);
            PG8_WAIT_V(8); PG8_WAIT_L(0); PG8_BAR; PG8_MMA(1, 0, At, B0); PG8_MMA(1, 1, At, B1); PG8_BAR; PG8_SCHED;
            } else {
            PG8_LDB(B0, 0, 0); PG8_SCHED; PG8_LDA(At, 0, 0); PG8_STAGE(PG8_SA(1, 1), a1 + hstep, voffA);
            PG8_WAIT_L(8); PG8_BAR; PG8_WAIT_L(0); PG8_MMA(0, 0, At, B0); PG8_BAR; PG8_SCHED;
            PG8_LDB(B1, 0, 1); PG8_STAGE(PG8_SB(0, 0), b2, voffB);
            PG8_BAR; PG8_WAIT_L(0); PG8_MMA(0, 1, At, B1); PG8_BAR;
            PG8_LDA(At, 0, 1); PG8_STAGE(PG8_SA(0, 0), a2, voffA);
            PG8_BAR; PG8_WAIT_L(0); PG8_MMA(1, 0, At, B0); PG8_BAR; PG8_SCHED;
            PG8_STAGE(PG8_SB(0, 1), b2 + hstep, voffB);
            PG8_WAIT_V(6); PG8_BAR; PG8_MMA(1, 1, At, B1); PG8_BAR;
            PG8_LDB(B0, 1, 0); PG8_SCHED; PG8_LDA(At, 1, 0); PG8_STAGE(PG8_SA(0, 1), a2 + hstep, voffA);
            PG8_WAIT_L(8); PG8_BAR; PG8_WAIT_L(0); PG8_MMA(0, 0, At, B0); PG8_BAR; PG8_SCHED;
            PG8_LDB(B1, 1, 1); PG8_STAGE(PG8_SB(1, 0), b3, voffB);
            PG8_BAR; PG8_WAIT_L(0); PG8_MMA(0, 1, At, B1); PG8_BAR;
            PG8_LDA(At, 1, 1); PG8_STAGE(PG8_SA(1, 0), a3, voffA);
            PG8_BAR; PG8_WAIT_L(0); PG8_MMA(1, 0, At, B0); PG8_BAR; PG8_SCHED;
            PG8_STAGE(PG8_SB(1, 1), b3 + hstep, voffB);
            PG8_WAIT_V(6); PG8_BAR; PG8_MMA(1, 1, At, B1); PG8_BAR;
            }
        }
        if constexpr (ALIGN_EPI) { if (wr == 0) PG8_BAR; }
        E(acc, cur, wr, wc, fr, fq); S.done(cur);
        if (!has_next) break;
#pragma unroll
        for (int a = 0; a < 2; ++a)
#pragma unroll
            for (int b = 0; b < 2; ++b)
#pragma unroll
                for (int m = 0; m < 4; ++m)
#pragma unroll
                    for (int n = 0; n < 2; ++n) acc[a][b][m][n] = (f32x4){0.f, 0.f, 0.f, 0.f};
        cur = nxt; cA = nA; cB = nB; ++ui;
        if constexpr (ALIGN_EPI) { if (wr == 1) PG8_BAR; }
    }
    PG8_WAIT_V(0);
    if constexpr (!ALIGN_EPI) { if (wr == 0) PG8_BAR; }
    PG8_BAR;
#undef PG8_SA
#undef PG8_SB
#undef PG8_STAGE
#undef PG8_LDA
#undef PG8_LDB
#undef PG8_MMA
#undef PG8_WAIT_V
#undef PG8_WAIT_L
#undef PG8_BAR
#undef PG8_SCHED
}
}

constexpr int NWAVES = 8;
constexpr size_t MiB = 1u << 20;
constexpr size_t WS_CTL = 0, CTL_ZERO_BYTES = 1 * MiB;
constexpr size_t WL_IN = 0, WL_PABC = 46 * MiB, WL_O = 54 * MiB, WL_UP = 62 * MiB, WL_DOWN = 94 * MiB, WL_STRIDE = 126 * MiB;
constexpr size_t WS_W = 1 * MiB;
constexpr size_t WS_H = WS_W + DEPTH * WL_STRIDE;
constexpr size_t WS_PROJ = WS_H + 32 * MiB;
constexpr size_t WS_Z = WS_PROJ + 184 * MiB;
constexpr size_t WS_MIX = WS_Z + 32 * MiB;
constexpr size_t WS_Y = WS_MIX + 32 * MiB;
constexpr size_t WS_F = WS_Y + 64 * MiB;
constexpr size_t WS_END = WS_F + 128 * MiB;
static_assert((size_t)NIN * D * 2 == 46 * MiB && (size_t)M * NIN * 2 == 184 * MiB, "map");
constexpr int CW_TMO = 0, CW_CODE = 1, CW_BAR = 4096;

constexpr int RING_OFF = 0, PHASE_LDS = 143360;
constexpr int LDSCTL_OFF = PHASE_LDS, MISC_OFF = LDSCTL_OFF + 320, LDS_BYTES = 147456;

#define GAS __attribute__((address_space(1)))
#define LAS __attribute__((address_space(3)))
typedef unsigned short bf16;
typedef unsigned v4u __attribute__((ext_vector_type(4)));
typedef unsigned v2u __attribute__((ext_vector_type(2)));
typedef float f32x4 __attribute__((ext_vector_type(4)));
typedef GAS unsigned gu32;
#define RLX_AGENT __ATOMIC_RELAXED, __HIP_MEMORY_SCOPE_AGENT
#define LDS_WAIT() asm volatile("s_waitcnt lgkmcnt(0)" ::: "memory")
#define VM_WAIT() asm volatile("s_waitcnt vmcnt(0)" ::: "memory")
using pg8::cvt_pk_bf16; using pg8::bf_lo; using pg8::bf_hi;

#define XB_TMO      128
#define XB_XCNT(j)  (256  + 64 * (j))
#define XB_XSUB(j)  (1280 + 64 * (j))
#define XB_XGEN(j)  (2304 + 64 * (j))
#define XB_TOP      3328
#define XB_TOPGEN   3392
#define XCD_BAR_WORDS 3456
#define XB_SPIN_CAP (1u << 18)
__device__ __forceinline__ unsigned xb_ld(unsigned* p)              { return __hip_atomic_load(p, __ATOMIC_RELAXED, __HIP_MEMORY_SCOPE_AGENT); }
__device__ __forceinline__ unsigned xb_add(unsigned* p, unsigned v) { return __hip_atomic_fetch_add(p, v, __ATOMIC_RELAXED, __HIP_MEMORY_SCOPE_AGENT); }
__device__ __forceinline__ unsigned xb_xcc_id() { return (unsigned)__builtin_amdgcn_s_getreg((3 << 11) | 20) & 0xFu; }
#define XB_SPIN(cond, bar) do { unsigned _sp = 0; while (cond) { __builtin_amdgcn_s_sleep(1); \
    if ((++_sp & 255u) == 0u) { if (xb_ld(&(bar)[XB_TMO])) break; if (_sp > XB_SPIN_CAP) { atomicAdd(&(bar)[XB_TMO], 1u); break; } } } } while (0)
struct XcdBarrier { unsigned* bar; unsigned x; volatile LAS unsigned* st; };
__device__ __forceinline__ XcdBarrier xcd_barrier_post(unsigned* bar, volatile LAS unsigned* st) {
    XcdBarrier b; b.bar = bar; b.x = xb_xcc_id(); b.st = st;
    if (threadIdx.x == 0) (void)xb_add(&bar[XB_XCNT(b.x)], 1u);
    return b;
}
__device__ __forceinline__ void xcd_barrier_complete(unsigned* bar, unsigned x, unsigned& nloc, unsigned& nx) {
    const unsigned G = gridDim.x * gridDim.y * gridDim.z;
    unsigned sum, cnt, mine, sp = 0u;
    for (;;) {
        sum = 0u; cnt = 0u; mine = 0u;
#pragma unroll
        for (unsigned j = 0; j < 16; ++j) { const unsigned c = xb_ld(&bar[XB_XCNT(j)]); sum += c; cnt += (c > 0u) ? 1u : 0u; mine = (j == x) ? c : mine; }
        if (sum == G) break;
        __builtin_amdgcn_s_sleep(1);
        if ((++sp & 255u) == 0u) { if (xb_ld(&bar[XB_TMO])) break; if (sp > XB_SPIN_CAP) { atomicAdd(&bar[XB_TMO], 1u); break; } }
    }
    nloc = mine > 0u ? mine : 1u; nx = cnt > 0u ? cnt : 1u;
}
__device__ __forceinline__ void xcd_barrier(const XcdBarrier& b) {
    asm volatile("s_waitcnt vmcnt(0)" ::: "memory");
    __syncthreads();
    if (threadIdx.x == 0) {
        unsigned* bar = b.bar;
        __builtin_amdgcn_s_waitcnt(0);
        unsigned nloc = b.st[0], nx = b.st[1];
        if (nloc == 0u) { xcd_barrier_complete(bar, b.x, nloc, nx); b.st[0] = nloc; b.st[1] = nx; }
        const unsigned old = xb_add(&bar[XB_XSUB(b.x)], 1u);
        const unsigned gen = old / nloc;
        if (old + 1u == (gen + 1u) * nloc) {
            __builtin_amdgcn_fence(__ATOMIC_RELEASE, "agent");
            asm volatile("s_waitcnt vmcnt(0)" ::: "memory");
            const unsigned og = xb_add(&bar[XB_TOP], 1u);
            const unsigned tg = og / nx;
            if (og + 1u == (tg + 1u) * nx) xb_add(&bar[XB_TOPGEN], 1u);
            else XB_SPIN(xb_ld(&bar[XB_TOPGEN]) == tg, bar);
            __builtin_amdgcn_fence(__ATOMIC_ACQUIRE, "agent");
            xb_add(&bar[XB_XGEN(b.x)], 1u);
            asm volatile("s_waitcnt vmcnt(0)" ::: "memory");
        } else {
            XB_SPIN(xb_ld(&bar[XB_XGEN(b.x)]) == gen, bar);
            __builtin_amdgcn_fence(__ATOMIC_ACQUIRE, "agent");
            asm volatile("s_waitcnt vmcnt(0)" ::: "memory");
        }
    }
    __syncthreads();
}

struct Frame {
    LAS unsigned char* lds;
    int vcu, G;
    const float *x, *ln_mix_pre, *ln_mix_post, *ln_mlp_pre, *ln_mlp_post, *w_in, *conv_a_w, *proj_a, *proj_b, *conv_c_w, *conv_c_b, *norm_c_g, *norm_c_b, *proj_c, *w_o, *w_up, *w_down;
    float* out;
    unsigned char* ws;
    bf16 *H, *PROJ, *Z, *MIX, *F; float* Y;
};
__device__ __forceinline__ bf16* wl(const Frame& F, int l, size_t off) { return (bf16*)(F.ws + WS_W + (size_t)l * WL_STRIDE + off); }

__device__ __forceinline__ int fresh_tid() { int t = threadIdx.x; asm volatile("" : "+v"(t)); return t; }
__device__ __forceinline__ float wave_sum(float v) {
#pragma unroll
    for (int o = 1; o < 64; o <<= 1) v += __shfl_xor(v, o);
    return v;
}

__device__ __forceinline__ void transpose_item(const float* __restrict__ W, int N, bf16* __restrict__ WT, int ldk, int koff, int kb, int nb, LAS float* scr, int lane) {
    const int k0 = kb * 64, n0 = nb * 64, kr = lane >> 4, n4 = lane & 15;
    f32x4 v[16];
#pragma unroll
    for (int i = 0; i < 16; ++i) v[i] = *(const GAS f32x4*)(W + (size_t)(k0 + 4 * i + kr) * N + n0 + 4 * n4);
#pragma unroll
    for (int i = 0; i < 16; ++i) { LAS float* s = scr + (4 * i + kr) * 65 + 4 * n4; s[0] = v[i].x; s[1] = v[i].y; s[2] = v[i].z; s[3] = v[i].w; }
    LDS_WAIT(); asm volatile("" ::: "memory");
    const int kc = lane >> 3, nr = lane & 7;
#pragma unroll
    for (int j = 0; j < 8; ++j) { const int n = 8 * j + nr; const LAS float* s = scr + (8 * kc) * 65 + n;
        v4u o; o.x = cvt_pk_bf16(s[0 * 65], s[1 * 65]); o.y = cvt_pk_bf16(s[2 * 65], s[3 * 65]); o.z = cvt_pk_bf16(s[4 * 65], s[5 * 65]); o.w = cvt_pk_bf16(s[6 * 65], s[7 * 65]);
        *(GAS v4u*)(WT + (size_t)(n0 + n) * ldk + koff + k0 + 8 * kc) = o; }
    LDS_WAIT(); asm volatile("" ::: "memory");
}
__device__ __forceinline__ void rms_row_to_bf16(const float* xrow, const float* gain, bf16* orow, int lane) {
    const GAS f32x4* xr = (const GAS f32x4*)xrow + lane; const GAS f32x4* gr = (const GAS f32x4*)gain + lane;
    f32x4 v[8]; float s = 0.f;
#pragma unroll
    for (int j = 0; j < 8; ++j) { v[j] = xr[64 * j]; s += (v[j].x * v[j].x + v[j].y * v[j].y) + (v[j].z * v[j].z + v[j].w * v[j].w); }
    const float r = 1.0f / sqrtf(wave_sum(s) * (1.f / D) + RMS_EPS);
    GAS v2u* o8 = (GAS v2u*)orow + lane;
#pragma unroll
    for (int j = 0; j < 8; ++j) { const f32x4 g = gr[64 * j]; v2u o; o.x = cvt_pk_bf16(v[j].x * r * g.x, v[j].y * r * g.y); o.y = cvt_pk_bf16(v[j].z * r * g.z, v[j].w * r * g.w); o8[64 * j] = o; }
}
__device__ __forceinline__ void p0_prologue(Frame& F) {
    const int tid = fresh_tid(), lane = tid & 63, wave = __builtin_amdgcn_readfirstlane(tid >> 6);
    LAS float* scr = (LAS float*)(F.lds + RING_OFF) + wave * (64 * 65);
    const int gw = F.vcu * NWAVES + wave, NGW = F.G * NWAVES;
    constexpr int I_IN = (D / 64) * (NIN / 64), I_A = (DSC / 64) * (D / 64), I_B = (DATT / 64) * (D / 64), I_C = (DCF / 64) * (D / 64), I_O = (D / 64) * (D / 64), I_UP = (D / 64) * (DFF / 64), I_DN = (DFF / 64) * (D / 64);
    constexpr int PER_L = I_IN + I_A + I_B + I_C + I_O + I_UP + I_DN;
    for (int it = gw; it < DEPTH * PER_L; it += NGW) {
        const int l = it / PER_L; int r = it - l * PER_L;
        if (r < I_IN) { transpose_item(F.w_in + (size_t)l * D * NIN, NIN, wl(F, l, WL_IN), D, 0, r / (NIN / 64), r % (NIN / 64), scr, lane); continue; } r -= I_IN;
        if (r < I_A)  { transpose_item(F.proj_a + (size_t)l * DSC * D, D, wl(F, l, WL_PABC), D, Z_A, r / (D / 64), r % (D / 64), scr, lane); continue; } r -= I_A;
        if (r < I_B)  { transpose_item(F.proj_b + (size_t)l * DATT * D, D, wl(F, l, WL_PABC), D, Z_B, r / (D / 64), r % (D / 64), scr, lane); continue; } r -= I_B;
        if (r < I_C)  { transpose_item(F.proj_c + (size_t)l * DCF * D, D, wl(F, l, WL_PABC), D, Z_C, r / (D / 64), r % (D / 64), scr, lane); continue; } r -= I_C;
        if (r < I_O)  { transpose_item(F.w_o + (size_t)l * D * D, D, wl(F, l, WL_O), D, 0, r / (D / 64), r % (D / 64), scr, lane); continue; } r -= I_O;
        if (r < I_UP) { transpose_item(F.w_up + (size_t)l * D * DFF, DFF, wl(F, l, WL_UP), D, 0, r / (DFF / 64), r % (DFF / 64), scr, lane); continue; } r -= I_UP;
        transpose_item(F.w_down + (size_t)l * DFF * D, D, wl(F, l, WL_DOWN), DFF, 0, r / (D / 64), r % (D / 64), scr, lane);
    }
    for (int m = gw; m < M; m += NGW) rms_row_to_bf16(F.x + (size_t)m * D, F.ln_mix_pre, F.H + (size_t)m * D, lane);
}

__device__ __forceinline__ void norm_phase(Frame& F, const float* xprev, const float* g_post, const float* g_next) {
    const int tid = fresh_tid(), lane = tid & 63, wave = __builtin_amdgcn_readfirstlane(tid >> 6);
    const int gw = F.vcu * NWAVES + wave, NGW = F.G * NWAVES;
    for (int m = gw; m < M; m += NGW) {
        const GAS f32x4* yr = (const GAS f32x4*)(F.Y + (size_t)m * D) + lane; const GAS f32x4* xr = (const GAS f32x4*)(xprev + (size_t)m * D) + lane;
        const GAS f32x4* gp = (const GAS f32x4*)g_post + lane; GAS f32x4* xo = (GAS f32x4*)(F.out + (size_t)m * D) + lane;
        f32x4 y[8], x[8]; float s = 0.f;
#pragma unroll
        for (int j = 0; j < 8; ++j) { y[j] = yr[64 * j]; x[j] = xr[64 * j]; }
#pragma unroll
        for (int j = 0; j < 8; ++j) s += (y[j].x * y[j].x + y[j].y * y[j].y) + (y[j].z * y[j].z + y[j].w * y[j].w);
        const float r1 = 1.0f / sqrtf(wave_sum(s) * (1.f / D) + RMS_EPS);
        float s2 = 0.f;
#pragma unroll
        for (int j = 0; j < 8; ++j) { const f32x4 g = gp[64 * j]; x[j] = x[j] + (y[j] * r1) * g; xo[64 * j] = x[j]; s2 += (x[j].x * x[j].x + x[j].y * x[j].y) + (x[j].z * x[j].z + x[j].w * x[j].w); }
        if (g_next) {
            const float r2 = 1.0f / sqrtf(wave_sum(s2) * (1.f / D) + RMS_EPS);
            const GAS f32x4* gn = (const GAS f32x4*)g_next + lane; GAS v2u* o8 = (GAS v2u*)(F.H + (size_t)m * D) + lane;
#pragma unroll
            for (int j = 0; j < 8; ++j) { const f32x4 g = gn[64 * j]; v2u o; o.x = cvt_pk_bf16(x[j].x * r2 * g.x, x[j].y * r2 * g.y); o.y = cvt_pk_bf16(x[j].z * r2 * g.z, x[j].w * r2 * g.w); o8[64 * j] = o; }
        }
    }
}

__device__ __forceinline__ void unpack8(const v4u w, float (&f)[8]) { f[0] = bf_lo(w.x); f[1] = bf_hi(w.x); f[2] = bf_lo(w.y); f[3] = bf_hi(w.y); f[4] = bf_lo(w.z); f[5] = bf_hi(w.z); f[6] = bf_lo(w.w); f[7] = bf_hi(w.w); }
__device__ __forceinline__ v4u pack8(const float (&f)[8]) { v4u o; o.x = cvt_pk_bf16(f[0], f[1]); o.y = cvt_pk_bf16(f[2], f[3]); o.z = cvt_pk_bf16(f[4], f[5]); o.w = cvt_pk_bf16(f[6], f[7]); return o; }
__device__ __forceinline__ void conv_item(Frame& F, int l, int item) {
    const int b = item >> 6, t0 = (item & 63) * 32, rowbase = b * SEQ, tid = fresh_tid(), lane = tid & 63, wave = __builtin_amdgcn_readfirstlane(tid >> 6);
    LAS float* U = (LAS float*)(F.lds + RING_OFF);
    for (int idx = tid; idx < 62 * 64; idx += NWAVES * 64) {
        const int rr = idx >> 6, c8 = (idx & 63) * 8, t = t0 - 30 + rr; float u[8];
        if (t >= 0) { const bf16* p = F.PROJ + (size_t)(rowbase + t) * NIN + c8; float a[8], g[8]; unpack8(*(const GAS v4u*)(p + C_CA), a); unpack8(*(const GAS v4u*)(p + C_CG), g);
#pragma unroll
            for (int j = 0; j < 8; ++j) u[j] = a[j] * pg8::sigmoidf_fast(g[j]); }
        else {
#pragma unroll
            for (int j = 0; j < 8; ++j) u[j] = 0.f; }
        LAS f32x4* d = (LAS f32x4*)(U + rr * 512 + c8); d[0] = (f32x4){u[0], u[1], u[2], u[3]}; d[1] = (f32x4){u[4], u[5], u[6], u[7]};
    }
    __syncthreads();
    const int c8 = lane * 8;
    {
        float acc[4][8];
        { const GAS f32x4* bp = (const GAS f32x4*)(F.conv_c_b + (size_t)l * DCF + c8); const f32x4 b0 = bp[0], b1 = bp[1];
#pragma unroll
          for (int j = 0; j < 4; ++j) { acc[j][0] = b0.x; acc[j][1] = b0.y; acc[j][2] = b0.z; acc[j][3] = b0.w; acc[j][4] = b1.x; acc[j][5] = b1.y; acc[j][6] = b1.z; acc[j][7] = b1.w; } }
        const float* wbase = F.conv_c_w + (size_t)l * CFW * DCF + c8;
#pragma unroll 1
        for (int k = 0; k < CFW; ++k) {
            const GAS f32x4* wp = (const GAS f32x4*)(wbase + (size_t)k * DCF); const f32x4 w0 = wp[0], w1 = wp[1];
#pragma unroll
            for (int j = 0; j < 4; ++j) { const LAS f32x4* up = (const LAS f32x4*)(U + (4 * wave + j + k) * 512 + c8); const f32x4 u0 = up[0], u1 = up[1];
                acc[j][0] += w0.x * u0.x; acc[j][1] += w0.y * u0.y; acc[j][2] += w0.z * u0.z; acc[j][3] += w0.w * u0.w;
                acc[j][4] += w1.x * u1.x; acc[j][5] += w1.y * u1.y; acc[j][6] += w1.z * u1.z; acc[j][7] += w1.w * u1.w; }
        }
        const GAS f32x4* gp = (const GAS f32x4*)(F.norm_c_g + (size_t)l * DCF + c8); const GAS f32x4* bp = (const GAS f32x4*)(F.norm_c_b + (size_t)l * DCF + c8);
        const f32x4 g0 = gp[0], g1 = gp[1], e0 = bp[0], e1 = bp[1];
        const float gg[8] = {g0.x, g0.y, g0.z, g0.w, g1.x, g1.y, g1.z, g1.w}, ee[8] = {e0.x, e0.y, e0.z, e0.w, e1.x, e1.y, e1.z, e1.w};
#pragma unroll
        for (int j = 0; j < 4; ++j) {
            float s = 0.f;
#pragma unroll
            for (int q = 0; q < 8; ++q) s += acc[j][q];
            const float mean = wave_sum(s) * (1.f / DCF); float qq = 0.f;
#pragma unroll
            for (int q = 0; q < 8; ++q) { acc[j][q] -= mean; qq += acc[j][q] * acc[j][q]; }
            const float rstd = 1.0f / sqrtf(wave_sum(qq) * (1.f / DCF) + LN_EPS); float o[8];
#pragma unroll
            for (int q = 0; q < 8; ++q) { const float y = acc[j][q] * rstd * gg[q] + ee[q]; o[q] = y * pg8::sigmoidf_fast(y); }
            *(GAS v4u*)(F.Z + (size_t)(rowbase + t0 + 4 * wave + j) * D + Z_C + c8) = pack8(o);
        }
    }
    {
        const GAS f32x4* wp = (const GAS f32x4*)(F.conv_a_w + (size_t)l * SCW * DSC + c8);
        float w[3][8];
#pragma unroll
        for (int k = 0; k < 3; ++k) { const f32x4 a = wp[k * (DSC / 4)], c = wp[k * (DSC / 4) + 1]; w[k][0] = a.x; w[k][1] = a.y; w[k][2] = a.z; w[k][3] = a.w; w[k][4] = c.x; w[k][5] = c.y; w[k][6] = c.z; w[k][7] = c.w; }
#pragma unroll
        for (int j = 0; j < 4; ++j) { const int t = t0 + 4 * wave + j; float o[8];
#pragma unroll
            for (int q = 0; q < 8; ++q) o[q] = 0.f;
#pragma unroll
            for (int k = 0; k < 3; ++k) { const int ts = t - 2 + k;
                if (ts >= 0) { const bf16* p = F.PROJ + (size_t)(rowbase + ts) * NIN + c8; float cc[8], uu[8]; unpack8(*(const GAS v4u*)(p + C_SC), cc); unpack8(*(const GAS v4u*)(p + C_SU), uu);
#pragma unroll
                    for (int q = 0; q < 8; ++q) o[q] += w[k][q] * (cc[q] * uu[q]); } }
            float bb[8]; unpack8(*(const GAS v4u*)(F.PROJ + (size_t)(rowbase + t) * NIN + C_SB + c8), bb);
#pragma unroll
            for (int q = 0; q < 8; ++q) o[q] *= bb[q];
            *(GAS v4u*)(F.Z + (size_t)(rowbase + t) * D + Z_A + c8) = pack8(o);
        }
    }
    __syncthreads();
}

__device__ __forceinline__ void attn_simple_item(Frame& F, int id) {
    const int lane = fresh_tid() & 63, bh = id >> 6, jj = id & 63, qc = (jj & 1) ? 63 - (jj >> 1) : (jj >> 1);
    const int b = bh >> 3, h = bh & 7, qi = lane & 31, half = lane >> 5, t = qc * 32 + qi;
    const bf16* base = F.PROJ + (size_t)(b * SEQ) * NIN + h * HD + half * 64;
    float q[64], o[64];
    { const GAS v4u* qp = (const GAS v4u*)(base + (size_t)t * NIN + C_Q);
#pragma unroll
      for (int i = 0; i < 8; ++i) { float f[8]; unpack8(qp[i], f);
#pragma unroll
          for (int j = 0; j < 8; ++j) q[8 * i + j] = f[j]; } }
#pragma unroll
    for (int i = 0; i < 64; ++i) o[i] = 0.f;
    float carry = 1.f;
#pragma unroll 1
    for (int s = qc * 32 + 30; s >= 0; --s) {
        const GAS v4u* kp = (const GAS v4u*)(base + (size_t)s * NIN + C_K); const GAS v4u* vp = (const GAS v4u*)(base + (size_t)s * NIN + C_V);
        float z0 = 0.f, z1 = 0.f;
#pragma unroll
        for (int i = 0; i < 8; ++i) { float f[8]; unpack8(kp[i], f);
#pragma unroll
            for (int j = 0; j < 8; j += 2) { z0 += q[8 * i + j] * f[j]; z1 += q[8 * i + j + 1] * f[j + 1]; } }
        float z = z0 + z1; z += __shfl_xor(z, 32);
        const float e = __builtin_amdgcn_exp2f(fminf(-z, 100.f)), sg = __builtin_amdgcn_rcpf(1.f + e);
        const bool act = s < t;
        const float a = act ? sg * carry : 0.f;
        carry = act ? carry * (e * sg) : carry;
#pragma unroll
        for (int i = 0; i < 8; ++i) { float f[8]; unpack8(vp[i], f);
#pragma unroll
            for (int j = 0; j < 8; ++j) o[8 * i + j] += a * f[j]; }
    }
    GAS v4u* op = (GAS v4u*)(F.Z + (size_t)(b * SEQ + t) * D + Z_B + h * HD + half * 64);
#pragma unroll
    for (int i = 0; i < 8; ++i) { float f[8];
#pragma unroll
        for (int j = 0; j < 8; ++j) f[j] = o[8 * i + j];
        op[i] = pack8(f); }
}

namespace sba {
typedef short bf16x8 __attribute__((ext_vector_type(8)));
typedef short s16x4 __attribute__((ext_vector_type(4)));
typedef float f32x16 __attribute__((ext_vector_type(16)));
constexpr int SHM = 16384;
constexpr int LDS_V = 0, LDS_K = 2 * SHM;
#define SBA_KSWZ(row, colB) ((row) * 256 + ((colB) ^ (((row) & 7) << 4)))
__device__ __forceinline__ int v_st(int k, int c) { const int kk = (k & ~0xC) | ((k & 4) << 1) | ((k & 8) >> 1); return ((kk >> 3) * 4 + (c >> 5)) * 512 + ((kk & 7) * 32 + (c & 31)) * 2; }
__device__ __forceinline__ int v_rd_base(int lane) { return ((lane & 3) << 3) | (((lane >> 2) & 3) << 6) | (((lane >> 4) & 1) << 5) | (((lane >> 5) & 1) << 8); }
constexpr int v_rd_off(int d0, int ks, int half) { return d0 * 512 + ks * 4096 + half * 2048; }
__device__ __forceinline__ int crow(int r, int hi) { return (r & 3) + 8 * (r >> 2) + 4 * hi; }
__device__ __forceinline__ unsigned cvtpk(float lo, float hi) { unsigned r; asm("v_cvt_pk_bf16_f32 %0, %1, %2" : "=v"(r) : "v"(lo), "v"(hi)); return r; }

__device__ __forceinline__ void qkt(f32x16& p0, f32x16& p1, const LAS unsigned char* Kb, int r32, int hi, const bf16x8* qr) {
    p0 = f32x16{}; p1 = f32x16{};
    const LAS unsigned char* kb[4];
#pragma unroll
    for (int dd = 0; dd < 4; ++dd) kb[dd] = Kb + SBA_KSWZ(r32, (dd * 16 + hi * 8) * 2);
#pragma unroll
    for (int d0 = 0; d0 < 8; ++d0) { const LAS unsigned char* a = kb[d0 & 3] + (d0 >> 2) * 128;
        const bf16x8 b0 = *(const LAS bf16x8*)a, b1 = *(const LAS bf16x8*)(a + 32 * 256);
        p0 = __builtin_amdgcn_mfma_f32_32x32x16_bf16(b0, qr[d0], p0, 0, 0, 0);
        p1 = __builtin_amdgcn_mfma_f32_32x32x16_bf16(b1, qr[d0], p1, 0, 0, 0); }
}
__device__ __forceinline__ void pv_tile(f32x16* o, int vb, bf16x8 pa0, bf16x8 pa1, bf16x8 pa2, bf16x8 pa3) {
#define SBA_TRRD(dst, off) asm volatile("ds_read_b64_tr_b16 %0, %1 offset:%2" : "=&v"(dst) : "v"(vb), "i"(off) : "memory")
#define SBA_PV_D0(d0) do { s16x4 l0, l1, l2, l3, h0, h1, h2, h3; constexpr int b_ = v_rd_off(d0, 0, 0); \
        SBA_TRRD(l0, b_); SBA_TRRD(h0, b_ + 2048); SBA_TRRD(l1, b_ + 4096); SBA_TRRD(h1, b_ + 6144); SBA_TRRD(l2, b_ + 8192); SBA_TRRD(h2, b_ + 10240); SBA_TRRD(l3, b_ + 12288); SBA_TRRD(h3, b_ + 14336); \
        asm volatile("s_waitcnt lgkmcnt(0)" ::: "memory"); __builtin_amdgcn_sched_barrier(0); \
        o[d0] = __builtin_amdgcn_mfma_f32_32x32x16_bf16(pa0, (bf16x8){l0[0], l0[1], l0[2], l0[3], h0[0], h0[1], h0[2], h0[3]}, o[d0], 0, 0, 0); \
        o[d0] = __builtin_amdgcn_mfma_f32_32x32x16_bf16(pa1, (bf16x8){l1[0], l1[1], l1[2], l1[3], h1[0], h1[1], h1[2], h1[3]}, o[d0], 0, 0, 0); \
        o[d0] = __builtin_amdgcn_mfma_f32_32x32x16_bf16(pa2, (bf16x8){l2[0], l2[1], l2[2], l2[3], h2[0], h2[1], h2[2], h2[3]}, o[d0], 0, 0, 0); \
        o[d0] = __builtin_amdgcn_mfma_f32_32x32x16_bf16(pa3, (bf16x8){l3[0], l3[1], l3[2], l3[3], h3[0], h3[1], h3[2], h3[3]}, o[d0], 0, 0, 0); } while (0)
    SBA_PV_D0(0); SBA_PV_D0(1); SBA_PV_D0(2); SBA_PV_D0(3);
#undef SBA_PV_D0
#undef SBA_TRRD
}
template <bool MASK>
__device__ __forceinline__ void stick(f32x16& p0, f32x16& p1, float& carry, int dq, bool hi, bf16x8& pa0, bf16x8& pa1, bf16x8& pa2, bf16x8& pa3) {
    float gp[8];
#pragma unroll
    for (int idx = 0; idx < 8; ++idx) { const int g = idx & 3; f32x16& p = (idx >> 2) ? p1 : p0; float sg[4], f[4];
#pragma unroll
        for (int i = 0; i < 4; ++i) { const float e = __builtin_amdgcn_exp2f(-p[4 * g + i]); float s_ = __builtin_amdgcn_rcpf(1.0f + e);
            if (MASK) s_ = ((8 * g + i + 32 * (idx >> 2)) < dq) ? s_ : 0.f;
            sg[i] = s_; f[i] = 1.0f - s_; }
        const float x2 = f[3], x1 = x2 * f[2], x0 = x1 * f[1];
        gp[idx] = x0 * f[0];
        p[4 * g + 3] = sg[3]; p[4 * g + 2] = sg[2] * x2; p[4 * g + 1] = sg[1] * x1; p[4 * g + 0] = sg[0] * x0; }
    float S = carry, E[8];
#pragma unroll
    for (int idx = 7; idx >= 0; --idx) {
        const auto rr = __builtin_amdgcn_permlane32_swap(__float_as_uint(gp[idx]), __float_as_uint(gp[idx]), false, false);
        const float glo = __uint_as_float(rr[0]), ghi = __uint_as_float(rr[1]);
        const float Ehi = S; S *= ghi; const float Elo = S; S *= glo;
        E[idx] = hi ? Ehi : Elo; }
    carry = S;
#pragma unroll
    for (int idx = 0; idx < 8; ++idx) { const int g = idx & 3; f32x16& p = (idx >> 2) ? p1 : p0;
#pragma unroll
        for (int i = 0; i < 4; ++i) p[4 * g + i] *= E[idx]; }
#define SBA_PK4(P, B_, OUT) do { unsigned a0 = cvtpk(P[B_ + 0], P[B_ + 1]), a1 = cvtpk(P[B_ + 2], P[B_ + 3]), b0 = cvtpk(P[B_ + 4], P[B_ + 5]), b1 = cvtpk(P[B_ + 6], P[B_ + 7]); \
        auto r0 = __builtin_amdgcn_permlane32_swap(a0, b0, false, false); auto r1 = __builtin_amdgcn_permlane32_swap(a1, b1, false, false); \
        v4u w = {r0[0], r1[0], r0[1], r1[1]}; OUT = __builtin_bit_cast(bf16x8, w); } while (0)
    SBA_PK4(p0, 0, pa0); SBA_PK4(p0, 8, pa1); SBA_PK4(p1, 0, pa2); SBA_PK4(p1, 8, pa3);
#undef SBA_PK4
}
__device__ __forceinline__ void attn_item(const bf16* PROJ, bf16* Z, LAS unsigned char* lds, int item) {
    const int tid = fresh_tid(), wid = __builtin_amdgcn_readfirstlane(tid >> 6), lane = tid & 63, r32 = lane & 31, hi = lane >> 5;
    const int bh = item >> 3, qb = 7 - (item & 7), b = bh >> 3, h = bh & 7;
    const bf16* base = PROJ + (size_t)(b * SEQ) * NIN + h * HD;
    const int T0 = qb * 256 + wid * 32;
    bf16x8 qr[8];
#pragma unroll
    for (int d0 = 0; d0 < 8; ++d0) qr[d0] = *(const GAS bf16x8*)(base + (size_t)(T0 + r32) * NIN + C_Q + d0 * 16 + hi * 8);
    const int sr = tid >> 4, sc = (tid & 15) * 8, vst0 = v_st(sr, sc), vst1 = v_st(32 + sr, sc), kws = SBA_KSWZ(sr, sc * 2);
    const int vb0 = (int)(uintptr_t)(lds + LDS_V) + v_rd_base(lane);
    const int NT = 4 * qb + 4;
    bf16x8 st_k0, st_k1, st_v0, st_v1;
#define SBA_LOAD(j) do { const bf16* rp = base + (size_t)((j) * 64 + sr) * NIN + sc; \
        st_k0 = *(const GAS bf16x8*)(rp + C_K); st_k1 = *(const GAS bf16x8*)(rp + (size_t)32 * NIN + C_K); st_v0 = *(const GAS bf16x8*)(rp + C_V); st_v1 = *(const GAS bf16x8*)(rp + (size_t)32 * NIN + C_V); } while (0)
#define SBA_WRITE(bf) do { *(LAS bf16x8*)(lds + LDS_K + (bf) * SHM + kws) = st_k0; *(LAS bf16x8*)(lds + LDS_K + (bf) * SHM + kws + 32 * 256) = st_k1; \
        *(LAS bf16x8*)(lds + LDS_V + (bf) * SHM + vst0) = st_v0; *(LAS bf16x8*)(lds + LDS_V + (bf) * SHM + vst1) = st_v1; } while (0)
    SBA_LOAD(NT - 1); SBA_WRITE(0);
    LAS unsigned* dflag = (LAS unsigned*)(lds + 4 * SHM);
    if (tid < 16) dflag[tid] = 0u;
    __syncthreads();
    f32x16 o[4] = {}; float carry = 1.0f; bool dead = false;
    for (int tt = 0; tt < NT; ++tt) {
        const int j = NT - 1 - tt, cur = tt & 1, kb = j * 64;
        if (tt > 0) { const v4u f0 = *(const LAS v4u*)(dflag + (cur ^ 1) * 8), f1 = *(const LAS v4u*)(dflag + (cur ^ 1) * 8 + 4);
            if ((f0.x & f0.y & f0.z & f0.w & f1.x & f1.y & f1.z & f1.w) != 0u) break; }
        if (tt + 1 < NT) SBA_LOAD(j - 1);
        if (kb <= T0 + 30 && !dead) {
            f32x16 p0, p1; bf16x8 pa0, pa1, pa2, pa3;
            qkt(p0, p1, lds + LDS_K + cur * SHM, r32, hi, qr);
            if (kb + 63 >= T0) stick<true>(p0, p1, carry, T0 + r32 - kb - 4 * hi, hi != 0, pa0, pa1, pa2, pa3);
            else stick<false>(p0, p1, carry, 0, hi != 0, pa0, pa1, pa2, pa3);
            pv_tile(o, vb0 + cur * SHM, pa0, pa1, pa2, pa3);
            dead = __all(carry == 0.0f) != 0;
        }
        if (lane == 0) dflag[cur * 8 + wid] = dead ? 1u : 0u;
        if (tt + 1 < NT) SBA_WRITE(cur ^ 1);
        __syncthreads();
    }
#undef SBA_LOAD
#undef SBA_WRITE
    bf16* Ow = Z + (size_t)(b * SEQ + T0) * D + Z_B + h * HD;
#pragma unroll
    for (int r = 0; r < 16; ++r) { const int orow = crow(r, hi);
#pragma unroll
        for (int d0 = 0; d0 < 4; ++d0) { const float v = o[d0][r], vn = __shfl_xor(v, 1);
            if ((r32 & 1) == 0) *(GAS unsigned*)(Ow + (size_t)orow * D + d0 * 32 + r32) = cvtpk(v, vn); } }
    __syncthreads();
}
}

struct Args { const float* in[17]; float* out; unsigned char* ws; int l_lo, l_hi, ph_lo, ph_hi; };
constexpr int NPH = 9;
__global__ void __launch_bounds__(NWAVES * 64, 2) mega_fwd(Args args) {
    extern __shared__ __attribute__((aligned(16))) unsigned char lds[];
    Frame F;
    F.lds = (LAS unsigned char*)lds;
    F.G = gridDim.x; { const int bx = blockIdx.x; F.vcu = (F.G % 8 == 0) ? (bx % 8) * (F.G / 8) + bx / 8 : bx; }
    F.x = args.in[0]; F.ln_mix_pre = args.in[1]; F.ln_mix_post = args.in[2]; F.ln_mlp_pre = args.in[3]; F.ln_mlp_post = args.in[4]; F.w_in = args.in[5]; F.conv_a_w = args.in[6];
    F.proj_a = args.in[7]; F.proj_b = args.in[8]; F.conv_c_w = args.in[9]; F.conv_c_b = args.in[10]; F.norm_c_g = args.in[11]; F.norm_c_b = args.in[12]; F.proj_c = args.in[13];
    F.w_o = args.in[14]; F.w_up = args.in[15]; F.w_down = args.in[16]; F.out = args.out; F.ws = args.ws;
    F.H = (bf16*)(F.ws + WS_H); F.PROJ = (bf16*)(F.ws + WS_PROJ); F.Z = (bf16*)(F.ws + WS_Z); F.MIX = (bf16*)(F.ws + WS_MIX); F.F = (bf16*)(F.ws + WS_F); F.Y = (float*)(F.ws + WS_Y);
    gu32* ctl = (gu32*)(F.ws + WS_CTL);
    for (int u = threadIdx.x; u < (LDS_BYTES - LDSCTL_OFF) / 4; u += NWAVES * 64) ((LAS unsigned*)(F.lds + LDSCTL_OFF))[u] = 0u;
    __syncthreads();
#if MK_MULTI
#define SEAM() do { } while (0)
#else
    XcdBarrier bar = xcd_barrier_post((unsigned*)(ctl + CW_BAR), (volatile LAS unsigned*)(F.lds + MISC_OFF) + 8);
#define SEAM() xcd_barrier(bar)
#endif
    const int lo = args.ph_lo, hi = args.ph_hi;
#define IN(k) (lo <= (k) && (k) < hi)
    for (int l = args.l_lo; l < args.l_hi; ++l) {
        if (l == 0 && IN(0)) {
#if !MK_SKEL && ((PH_MASK >> 0) & 1)
            for (int rep_ = 0; rep_ < 1 + ((PROBE_DUP >> 0) & 1); ++rep_) {
            p0_prologue(F);
            }
#endif
            SEAM();
        }
        if (IN(1)) {
#if !MK_SKEL && ((PH_MASK >> 1) & 1)
            for (int rep_ = 0; rep_ < 1 + ((PROBE_DUP >> 1) & 1); ++rep_) {
            pg8::Gemm g{F.H, wl(F, l, WL_IN), M, NIN, D}; pg8::StaticOrder S; S.init(M, NIN, F.G, (int)blockIdx.x);
            pg8::EpiIn E{F.PROJ};
            pg8::gemm_phase<pg8::EpiIn, pg8::StaticOrder, true, true>(F.lds + RING_OFF, g, S, E);
            }
#endif
            SEAM();
        }
        if (IN(2)) {
#if !MK_SKEL && ((PH_MASK >> 2) & 1)
            for (int rep_ = 0; rep_ < 1 + ((PROBE_DUP >> 2) & 1); ++rep_) {
            for (int it = F.vcu; it < BATCH * (SEQ / 32); it += F.G) conv_item(F, l, it);
#if ATTN_SIMPLE
            for (int id = F.vcu * NWAVES + __builtin_amdgcn_readfirstlane(fresh_tid() >> 6); id < BATCH * NHEAD * (SEQ / 32); id += F.G * NWAVES) attn_simple_item(F, id);
#else
            for (int it = F.vcu; it < BATCH * NHEAD * (SEQ / 256); it += F.G) sba::attn_item(F.PROJ, F.Z, F.lds + RING_OFF, it);
            }
#endif
#endif
            SEAM();
        }
        if (IN(3)) {
#if !MK_SKEL && ((PH_MASK >> 3) & 1)
            for (int rep_ = 0; rep_ < 1 + ((PROBE_DUP >> 3) & 1); ++rep_) {
            pg8::Gemm g{F.Z, wl(F, l, WL_PABC), M, D, D}; pg8::StaticOrder S; S.init(M, D, F.G, (int)blockIdx.x);
            pg8::EpiMix E{F.MIX, F.PROJ + C_G};
            pg8::gemm_phase<pg8::EpiMix, pg8::StaticOrder, true, true>(F.lds + RING_OFF, g, S, E);
            }
#endif
            SEAM();
        }
        if (IN(4)) {
#if !MK_SKEL && ((PH_MASK >> 4) & 1)
            for (int rep_ = 0; rep_ < 1 + ((PROBE_DUP >> 4) & 1); ++rep_) {
            pg8::Gemm g{F.MIX, wl(F, l, WL_O), M, D, D}; pg8::StaticOrder S; S.init(M, D, F.G, (int)blockIdx.x);
            pg8::EpiF32 E{F.Y, D};
            pg8::gemm_phase<pg8::EpiF32, pg8::StaticOrder, true, true>(F.lds + RING_OFF, g, S, E);
            }
#endif
            SEAM();
        }
        if (IN(5)) {
#if !MK_SKEL && ((PH_MASK >> 5) & 1)
            for (int rep_ = 0; rep_ < 1 + ((PROBE_DUP >> 5) & 1); ++rep_) {
            norm_phase(F, l == 0 ? F.x : F.out, F.ln_mix_post + (size_t)l * D, F.ln_mlp_pre + (size_t)l * D);
            }
#endif
            SEAM();
        }
        if (IN(6)) {
#if !MK_SKEL && ((PH_MASK >> 6) & 1)
            for (int rep_ = 0; rep_ < 1 + ((PROBE_DUP >> 6) & 1); ++rep_) {
            pg8::Gemm g{F.H, wl(F, l, WL_UP), M, DFF, D}; pg8::StaticOrder S; S.init(M, DFF, F.G, (int)blockIdx.x);
            pg8::EpiRelu2 E{F.F, DFF};
            pg8::gemm_phase<pg8::EpiRelu2, pg8::StaticOrder, true, true>(F.lds + RING_OFF, g, S, E);
            }
#endif
            SEAM();
        }
        if (IN(7)) {
#if !MK_SKEL && ((PH_MASK >> 7) & 1)
            for (int rep_ = 0; rep_ < 1 + ((PROBE_DUP >> 7) & 1); ++rep_) {
            pg8::Gemm g{F.F, wl(F, l, WL_DOWN), M, D, DFF}; pg8::StaticOrder S; S.init(M, D, F.G, (int)blockIdx.x);
            pg8::EpiF32 E{F.Y, D};
            pg8::gemm_phase<pg8::EpiF32, pg8::StaticOrder, true, true>(F.lds + RING_OFF, g, S, E);
            }
#endif
            SEAM();
        }
        if (IN(8)) {
#if !MK_SKEL && ((PH_MASK >> 8) & 1)
            for (int rep_ = 0; rep_ < 1 + ((PROBE_DUP >> 8) & 1); ++rep_) {
            norm_phase(F, F.out, F.ln_mlp_post + (size_t)l * D, (l + 1 < DEPTH) ? F.ln_mix_pre + (size_t)(l + 1) * D : nullptr);
            }
#endif
            if (l + 1 < DEPTH) SEAM();
        }
    }
#undef IN
}

extern "C" void kernel_launch(void* const* d_in, const int* in_sizes, int n_in, void* d_out, int out_size, void* d_ws, size_t ws_size, hipStream_t stream) {
    static int grid = 0;
    if (grid == 0) {
        if (n_in != 17 || in_sizes[0] != M * D || out_size != M * D || ws_size < WS_END) { fprintf(stderr, "kernel_launch: unexpected shapes (n_in %d, in0 %d, out %d, ws %zu < %zu)\n", n_in, n_in > 0 ? in_sizes[0] : -1, out_size, ws_size, (size_t)WS_END); grid = -1; return; }
        int dev = 0, cus = 0, per_cu = 0;
        if (hipGetDevice(&dev) != hipSuccess || hipDeviceGetAttribute(&cus, hipDeviceAttributeMultiprocessorCount, dev) != hipSuccess) { grid = -1; return; }
        if (hipFuncSetAttribute((const void*)mega_fwd, hipFuncAttributeMaxDynamicSharedMemorySize, LDS_BYTES) != hipSuccess) { fprintf(stderr, "kernel_launch: hipFuncSetAttribute failed\n"); grid = -1; return; }
        if (hipOccupancyMaxActiveBlocksPerMultiprocessor(&per_cu, (const void*)mega_fwd, NWAVES * 64, LDS_BYTES) != hipSuccess || per_cu < 1) { fprintf(stderr, "kernel_launch: occupancy query says %d\n", per_cu); (void)hipGetLastError(); per_cu = 1; }
        grid = cus;
    }
    if (grid < 0) return;
    if (hipMemsetAsync((char*)d_ws + WS_CTL, 0, CTL_ZERO_BYTES, stream) != hipSuccess) return;
    Args a{};
    for (int i = 0; i < 17; ++i) a.in[i] = (const float*)d_in[i];
    a.out = (float*)d_out; a.ws = (unsigned char*)d_ws;
#if MK_MULTI
    for (int l = 0; l < DEPTH; ++l)
        for (int p = (l == 0 ? 0 : 1); p < NPH; ++p) { a.l_lo = l; a.l_hi = l + 1; a.ph_lo = p; a.ph_hi = p + 1; hipLaunchKernelGGL(mega_fwd, dim3(grid), dim3(NWAVES * 64), LDS_BYTES, stream, a); }
#else
    a.l_lo = 0; a.l_hi = DEPTH; a.ph_lo = 0; a.ph_hi = NPH;
    hipLaunchKernelGGL(mega_fwd, dim3(grid), dim3(NWAVES * 64), LDS_BYTES, stream, a);
#endif
}
```
